# Optimizing an MI355X kernel written in HIP

```python
import jax, jax.numpy as jnp
from jax import lax
import numpy as np

D_MODEL = 2048
BATCH = 2
SEQ = 4096
DEPTH = 1

GRID_W = 64
CTX_LEN = 256
EPS = 1e-6
N_MOD = 6

N_FOURIER_GROUPS = 4
FOURIER_GROUP_DIM = 256
FOURIER_DIM = N_FOURIER_GROUPS * FOURIER_GROUP_DIM

MLA_HEADS = 8
QK_NOPE_DIM = 128
QK_ROPE_DIM = 64
QK_HEAD_DIM = QK_NOPE_DIM + QK_ROPE_DIM
V_HEAD_DIM = 128
Q_LORA_RANK = 768
KV_LORA_RANK = 512
MLA_DIM = MLA_HEADS * V_HEAD_DIM
ROPE_THETA = 10000.0
Q_BLOCK = 128

MIX_DIM = FOURIER_DIM + MLA_DIM
Q_OFF = FOURIER_DIM
KV_OFF = Q_OFF + Q_LORA_RANK
ROPE_OFF = KV_OFF + KV_LORA_RANK
IN_PROJ_DIM = ROPE_OFF + QK_ROPE_DIM

N_GROUPS = 8
EXPERTS_PER_GROUP = 8
N_EXPERTS = N_GROUPS * EXPERTS_PER_GROUP
TOP_K = 2
D_EXPERT = 768
MOE_BLOCK = 128

kernel_name = 'hybrid_fourier_mla_hmoe_dit_block'


def rms_norm(x, g):
    xf = x.astype(jnp.float32)
    y = xf * lax.rsqrt(jnp.mean(xf * xf, axis=-1, keepdims=True) + EPS)
    return (y * g.astype(jnp.float32)).astype(x.dtype)


def modulate(h, shift, scale):
    return h * (1 + scale) + shift


def ada_mod(cond, w_ada, b_ada):
    m = jax.nn.silu(cond) @ w_ada + b_ada
    return jnp.split(m, N_MOD, axis=-1)


def axial_rope_tables(n_tokens):
    rows = n_tokens // GRID_W
    row = jnp.repeat(jnp.arange(rows, dtype=jnp.int32), GRID_W).astype(jnp.float32)
    col = jnp.tile(jnp.arange(GRID_W, dtype=jnp.int32), rows).astype(jnp.float32)
    n_freq = QK_ROPE_DIM // 4
    inv = ROPE_THETA ** (-jnp.arange(n_freq, dtype=jnp.float32) / n_freq)
    ang_r = row[:, None] * inv[None, :]
    ang_c = col[:, None] * inv[None, :]
    return (jnp.cos(ang_r), jnp.sin(ang_r), jnp.cos(ang_c), jnp.sin(ang_c))


def rotate_half(x, cos, sin):
    x1, x2 = jnp.split(x, 2, axis=-1)
    cos = cos[None, :, None, :].astype(x.dtype)
    sin = sin[None, :, None, :].astype(x.dtype)
    return jnp.concatenate([x1 * cos - x2 * sin, x1 * sin + x2 * cos], axis=-1)


def apply_axial_rope(x, tables):
    cr, sr, cc, sc = tables
    xr, xcol = jnp.split(x, 2, axis=-1)
    return jnp.concatenate([rotate_half(xr, cr, sr), rotate_half(xcol, cc, sc)], axis=-1)


def mla_q(p, g_q_a, w_uq, g_qk_q, tables):
    b, n, _ = p.shape
    c_q = rms_norm(p[..., Q_OFF:KV_OFF], g_q_a)
    q = rms_norm((c_q @ w_uq).reshape(b, n, MLA_HEADS, QK_HEAD_DIM), g_qk_q)
    if tables is not None:
        q = jnp.concatenate([q[..., :QK_NOPE_DIM], apply_axial_rope(q[..., QK_NOPE_DIM:], tables)], axis=-1)
    return q


def mla_kv(p, g_kv_a, w_ukv, g_qk_k, tables):
    b, n, _ = p.shape
    c_kv = rms_norm(p[..., KV_OFF:ROPE_OFF], g_kv_a)
    k_rope = p[..., ROPE_OFF:]
    kv = (c_kv @ w_ukv).reshape(b, n, MLA_HEADS, QK_NOPE_DIM + V_HEAD_DIM)
    k_nope, v = jnp.split(kv, [QK_NOPE_DIM], axis=-1)
    k = jnp.concatenate([k_nope, jnp.broadcast_to(k_rope[:, :, None, :], (b, n, MLA_HEADS, QK_ROPE_DIM))], axis=-1)
    k = rms_norm(k, g_qk_k)
    if tables is not None:
        k = jnp.concatenate([k[..., :QK_NOPE_DIM], apply_axial_rope(k[..., QK_NOPE_DIM:], tables)], axis=-1)
    return k, v


def attend(q, k, v):
    sc = jnp.einsum('bqhd,bkhd->bhqk', q, k).astype(jnp.float32) * (QK_HEAD_DIM ** -0.5)
    pr = jax.nn.softmax(sc, axis=-1).astype(v.dtype)
    return jnp.einsum('bhqk,bkhd->bqhd', pr, v)


def block_attention(q, k, v):
    b, s, h, dq = q.shape
    nblk = s // Q_BLOCK
    qb = q.reshape(b, nblk, Q_BLOCK, h, dq).transpose(1, 0, 2, 3, 4)
    out = lax.map(lambda qblk: attend(qblk, k, v), qb)
    return out.transpose(1, 0, 2, 3, 4).reshape(b, s, h * V_HEAD_DIM)


def fourier_mix(p):
    b, n, _ = p.shape
    f = p[..., :FOURIER_DIM].reshape(b, n, N_FOURIER_GROUPS, FOURIER_GROUP_DIM).astype(jnp.float32)
    y = jnp.fft.fft2(f, axes=(1, 3), norm='ortho').real
    return y.reshape(b, n, FOURIER_DIM).astype(p.dtype)


def mix_out(four, attn, g_out_four, g_out_attn, w_out):
    y = jnp.concatenate([rms_norm(four, g_out_four), rms_norm(attn, g_out_attn)], axis=-1)
    return y @ w_out


def hier_moe(h, w_rg, b_rg, w_re, b_re, w_gate, w_up, w_down):
    b, n, d = h.shape
    n_tok = b * n
    t = h.reshape(n_tok, d)
    g_prob = jax.nn.softmax((t @ w_rg + b_rg).astype(jnp.float32), axis=-1)
    g_p, g_idx = lax.top_k(g_prob, 1)
    e_logits = (t @ w_re + b_re).astype(jnp.float32).reshape(n_tok, N_GROUPS, EXPERTS_PER_GROUP)
    e_logits = jnp.take_along_axis(e_logits, g_idx[:, :, None], axis=1)[:, 0]
    e_p, e_idx = lax.top_k(jax.nn.softmax(e_logits, axis=-1), TOP_K)
    e_p = e_p / jnp.sum(e_p, axis=-1, keepdims=True)
    weights = (g_p * e_p).reshape(-1)
    expert_ids = (g_idx * EXPERTS_PER_GROUP + e_idx).reshape(-1).astype(jnp.int32)
    token_ids = jnp.repeat(jnp.arange(n_tok, dtype=jnp.int32), TOP_K)
    n_slots = n_tok * TOP_K
    order = jnp.argsort(expert_ids)
    sorted_e = expert_ids[order]
    counts = jnp.zeros((N_EXPERTS,), jnp.int32).at[expert_ids].add(1)
    starts = jnp.cumsum(counts) - counts
    padded = (counts + MOE_BLOCK - 1) // MOE_BLOCK * MOE_BLOCK
    padded_ends = jnp.cumsum(padded)
    padded_starts = padded_ends - padded
    dest = padded_starts[sorted_e] + (jnp.arange(n_slots, dtype=jnp.int32) - starts[sorted_e])
    n_blocks = -(-(n_slots + N_EXPERTS * (MOE_BLOCK - 1)) // MOE_BLOCK)
    n_rows = n_blocks * MOE_BLOCK
    row_tok = jnp.full((n_rows,), n_tok, jnp.int32).at[dest].set(token_ids[order])
    row_w = jnp.zeros((n_rows,), jnp.float32).at[dest].set(weights[order])
    block_start = jnp.arange(n_blocks, dtype=jnp.int32) * MOE_BLOCK
    block_e = jnp.minimum(jnp.sum(block_start[:, None] >= padded_ends[None, :], axis=1), N_EXPERTS - 1)
    t_pad = jnp.concatenate([t, jnp.zeros((1, d), t.dtype)], axis=0)
    xb = t_pad[row_tok].reshape(n_blocks, MOE_BLOCK, d)

    def expert_block(args):
        xblk, e = args
        return (jax.nn.silu(xblk @ w_gate[e]) * (xblk @ w_up[e])) @ w_down[e]

    yb = lax.map(expert_block, (xb, block_e)).reshape(n_rows, d)
    out = jnp.zeros((n_tok + 1, d), t.dtype).at[row_tok].add(yb * row_w[:, None].astype(t.dtype))
    return out[:n_tok].reshape(b, n, d)


def setup_inputs(seed: int = 0) -> dict:
    key = jax.random.key(seed)
    ks = jax.random.split(key, 32)
    L, D = DEPTH, D_MODEL
    nrm = jax.random.normal
    f32 = jnp.float32
    return {
        'x': nrm(ks[0], (BATCH, SEQ, D), f32),
        'c': nrm(ks[1], (BATCH, D), f32),
        'ctx': nrm(ks[2], (BATCH, CTX_LEN, D), f32),
        'c_ctx': nrm(ks[3], (D,), f32),
        'w_ada': nrm(ks[4], (L, D, N_MOD * D), f32) * (0.3 * D ** -0.5),
        'b_ada': nrm(ks[5], (L, N_MOD * D), f32) * 0.02,
        'g_norm1': 1.0 + 0.02 * nrm(ks[6], (L, D), f32),
        'g_norm2': 1.0 + 0.02 * nrm(ks[7], (L, D), f32),
        'w_in': nrm(ks[8], (L, D, IN_PROJ_DIM), f32) * D ** -0.5,
        'g_q_a': 1.0 + 0.02 * nrm(ks[9], (L, Q_LORA_RANK), f32),
        'g_kv_a': 1.0 + 0.02 * nrm(ks[10], (L, KV_LORA_RANK), f32),
        'w_uq': nrm(ks[11], (L, Q_LORA_RANK, MLA_HEADS * QK_HEAD_DIM), f32) * Q_LORA_RANK ** -0.5,
        'w_ukv': nrm(ks[12], (L, KV_LORA_RANK, MLA_HEADS * (QK_NOPE_DIM + V_HEAD_DIM)), f32) * KV_LORA_RANK ** -0.5,
        'g_qk_q': 1.0 + 0.02 * nrm(ks[13], (L, QK_HEAD_DIM), f32),
        'g_qk_k': 1.0 + 0.02 * nrm(ks[14], (L, QK_HEAD_DIM), f32),
        'g_out_four': 1.0 + 0.02 * nrm(ks[15], (L, FOURIER_DIM), f32),
        'g_out_attn': 1.0 + 0.02 * nrm(ks[16], (L, MLA_DIM), f32),
        'w_out': nrm(ks[17], (L, MIX_DIM, D), f32) * MIX_DIM ** -0.5,
        'w_router_group': nrm(ks[18], (L, D, N_GROUPS), f32) * D ** -0.5,
        'b_router_group': nrm(ks[19], (L, N_GROUPS), f32) * 0.01,
        'w_router_expert': nrm(ks[20], (L, D, N_EXPERTS), f32) * D ** -0.5,
        'b_router_expert': nrm(ks[21], (L, N_EXPERTS), f32) * 0.01,
        'w_gate': nrm(ks[22], (L, N_EXPERTS, D, D_EXPERT), f32) * D ** -0.5,
        'w_up': nrm(ks[23], (L, N_EXPERTS, D, D_EXPERT), f32) * D ** -0.5,
        'w_down': nrm(ks[24], (L, N_EXPERTS, D_EXPERT, D), f32) * D_EXPERT ** -0.5,
    }


def reference(x, c, ctx, c_ctx, w_ada, b_ada, g_norm1, g_norm2, w_in, g_q_a, g_kv_a, w_uq, w_ukv, g_qk_q, g_qk_k,
              g_out_four, g_out_attn, w_out, w_router_group, b_router_group, w_router_expert, b_router_expert,
              w_gate, w_up, w_down):
    b, s, d = x.shape
    tables = axial_rope_tables(s)
    for l in range(DEPTH):
        sh1, sc1, gt1, sh2, sc2, gt2 = [m[:, None, :] for m in ada_mod(c, w_ada[l], b_ada[l])]
        csh1, csc1, cgt1, csh2, csc2, cgt2 = ada_mod(c_ctx, w_ada[l], b_ada[l])
        hx = modulate(rms_norm(x, g_norm1[l]), sh1, sc1)
        hc = modulate(rms_norm(ctx, g_norm1[l]), csh1, csc1)
        px = hx @ w_in[l]
        pc = hc @ w_in[l]
        kc, vc = mla_kv(pc, g_kv_a[l], w_ukv[l], g_qk_k[l], None)
        qx = mla_q(px, g_q_a[l], w_uq[l], g_qk_q[l], tables)
        kx, vx = mla_kv(px, g_kv_a[l], w_ukv[l], g_qk_k[l], tables)
        attn_x = block_attention(qx, jnp.concatenate([kx, kc], axis=1), jnp.concatenate([vx, vc], axis=1))
        four_x = fourier_mix(px)
        x_new = x + gt1 * mix_out(four_x, attn_x, g_out_four[l], g_out_attn[l], w_out[l])
        if l < DEPTH - 1:
            qc = mla_q(pc, g_q_a[l], w_uq[l], g_qk_q[l], None)
            attn_c = attend(qc, kc, vc).reshape(b, ctx.shape[1], MLA_DIM)
            four_c = fourier_mix(pc)
            ctx = ctx + cgt1 * mix_out(four_c, attn_c, g_out_four[l], g_out_attn[l], w_out[l])
            ctx = ctx + cgt2 * hier_moe(modulate(rms_norm(ctx, g_norm2[l]), csh2, csc2), w_router_group[l],
                                        b_router_group[l], w_router_expert[l], b_router_expert[l],
                                        w_gate[l], w_up[l], w_down[l])
        x = x_new
        hm = modulate(rms_norm(x, g_norm2[l]), sh2, sc2)
        x = x + gt2 * hier_moe(hm, w_router_group[l], b_router_group[l], w_router_expert[l], b_router_expert[l],
                               w_gate[l], w_up[l], w_down[l])
    return x
```

```cpp
#include <hip/hip_runtime.h>
#include <stdint.h>
#include <stdio.h>

namespace {
typedef unsigned short bf16_t;
constexpr int D = 2048, SEQ = 4096, NTOK = 8192, NCTX = 512, NROW = 8704;
constexpr int NH = 8, HQK = 192, HV = 128, NKEY = 4352;
constexpr int INP = 2368, NMOD = 12288;
constexpr int NEXP = 64, DE = 768, ECAP = 8192;
constexpr int WIN_ROWS = 3584;
constexpr float EPS = 1e-6f;

__device__ __forceinline__ float bf2f(bf16_t b) { return __uint_as_float(((unsigned)b) << 16); }
__device__ __forceinline__ bf16_t f2bf(float f) { unsigned u = __float_as_uint(f); u += 0x7FFFu + ((u >> 16) & 1u); return (bf16_t)(u >> 16); }
__device__ __forceinline__ float wave_sum(float v) { for (int o = 32; o >= 1; o >>= 1) v += __shfl_xor(v, o); return v; }
__device__ __forceinline__ float wave_max(float v) { for (int o = 32; o >= 1; o >>= 1) v = fmaxf(v, __shfl_xor(v, o)); return v; }

constexpr size_t al256(size_t x) { return (x + 255) / 256 * 256; }
constexpr size_t WS_CTL   = 0;
constexpr size_t WS_MOD   = 65536;
constexpr size_t WS_WINT  = WS_MOD   + al256((size_t)3 * NMOD * 4);
constexpr size_t WS_WUQT  = WS_WINT  + al256((size_t)WIN_ROWS * D * 2);
constexpr size_t WS_WUKVT = WS_WUQT  + al256((size_t)1536 * 768 * 2);
constexpr size_t WS_WOUTT = WS_WUKVT + al256((size_t)2048 * 512 * 2);
constexpr size_t WS_HX    = WS_WOUTT + al256((size_t)2048 * 2048 * 2);
constexpr size_t WS_G     = WS_HX    + al256((size_t)NROW * D * 2);
constexpr size_t WS_QL    = WS_G     + al256((size_t)NTOK * 2048 * 2);
constexpr size_t WS_KVL   = WS_QL    + al256((size_t)NTOK * 768 * 2);
constexpr size_t WS_ROPEK = WS_KVL   + al256((size_t)NROW * 512 * 2);
constexpr size_t WS_RSTDQ = WS_ROPEK + al256((size_t)NROW * 64 * 2);
constexpr size_t WS_RSTDKV= WS_RSTDQ + al256((size_t)NROW * 4);
constexpr size_t WS_QRAW  = WS_RSTDKV+ al256((size_t)NROW * 4);
constexpr size_t WS_KNRAW = WS_QRAW  + al256((size_t)NTOK * 1536 * 2);
constexpr size_t WS_VF    = WS_KNRAW + al256((size_t)NROW * 1024 * 2);
constexpr size_t WS_QF    = WS_VF    + al256((size_t)2 * NH * NKEY * HV * 2);
constexpr size_t WS_KF    = WS_QF    + al256((size_t)2 * NH * SEQ * HQK * 2);
constexpr size_t WS_ATT   = WS_KF    + al256((size_t)2 * NH * NKEY * HQK * 2);
constexpr size_t WS_T1    = WS_ATT   + al256((size_t)NTOK * 1024 * 2);
constexpr size_t WS_Y     = WS_T1    + al256((size_t)NTOK * 2048 * 2);
constexpr size_t WS_MIXA  = WS_Y     + al256((size_t)NTOK * 1024 * 2);
constexpr size_t WS_HM    = WS_MIXA  + al256((size_t)NTOK * 2048 * 2);
constexpr size_t WS_TOKE  = WS_HM    + al256((size_t)NTOK * 2048 * 2);
constexpr size_t WS_TOKP  = WS_TOKE  + al256((size_t)NTOK * 2 * 4);
constexpr size_t WS_SLTOK = WS_TOKP  + al256((size_t)NTOK * 2 * 4);
constexpr size_t WS_SLW   = WS_SLTOK + al256((size_t)NEXP * ECAP * 4);
constexpr size_t WS_H     = WS_SLW   + al256((size_t)NEXP * ECAP * 4);
constexpr size_t WS_YS    = WS_H     + al256((size_t)16384 * DE * 2);
constexpr size_t WS_SC    = WS_YS    + al256((size_t)16384 * D * 2);
constexpr size_t WS_END   = WS_SC    + al256((size_t)NH * SEQ * NKEY * 4);

__global__ void k_ada(const float* __restrict__ c, const float* __restrict__ cctx, const float* __restrict__ w, const float* __restrict__ b, float* __restrict__ mod) {
    __shared__ float sc[D];
    const int n = blockIdx.x * 256 + threadIdx.x, r = blockIdx.y;
    const float* cond = r < 2 ? c + r * D : cctx;
    for (int k = threadIdx.x; k < D; k += 256) { const float v = cond[k]; sc[k] = v / (1.f + expf(-v)); }
    __syncthreads();
    float acc = 0.f;
    for (int k = 0; k < D; ++k) acc += sc[k] * w[(size_t)k * NMOD + n];
    mod[r * NMOD + n] = acc + b[n];
}

__global__ void k_fold(const float* __restrict__ w_in, bf16_t* __restrict__ WinT) {
    __shared__ float tab[256];
    const int j = blockIdx.x, im = j >> 10, g = (j >> 8) & 3, kc = j & 255;
    { const int c = threadIdx.x, m = (c * kc) & 255; const float x = (float)m / 128.f; tab[c] = im ? -sinpif(x) : cospif(x); }
    __syncthreads();
    for (int k = threadIdx.x; k < D; k += 256) {
        const float* wr = w_in + (size_t)k * INP + g * 256; float acc = 0.f;
        for (int c = 0; c < 256; ++c) acc += wr[c] * tab[c];
        WinT[(size_t)j * D + k] = f2bf(acc);
    }
}

__global__ void k_tcvt(const float* __restrict__ in, const float* __restrict__ s0, const float* __restrict__ s1, bf16_t* __restrict__ out, int ldin, int coff, int K, int N, int ssplit, int ldo) {
    __shared__ float t[32][33];
    const int k0 = blockIdx.y * 32, n0 = blockIdx.x * 32, tx = threadIdx.x & 31, ty = threadIdx.x >> 5;
    for (int i = ty; i < 32; i += 8) { const int k = k0 + i, n = n0 + tx; float v = 0.f;
        if (k < K && n < N) { v = in[(size_t)k * ldin + coff + n]; if (s0) v *= (k < ssplit ? s0[k] : s1[k - ssplit]); }
        t[i][tx] = v; }
    __syncthreads();
    for (int i = ty; i < 32; i += 8) { const int n = n0 + i, k = k0 + tx; if (n < N && k < K) out[(size_t)n * ldo + k] = f2bf(t[tx][i]); }
}

__global__ void k_hx(const float* __restrict__ x, const float* __restrict__ ctx, const float* __restrict__ g1, const float* __restrict__ mod, bf16_t* __restrict__ HX) {
    const int row = blockIdx.x * 4 + (threadIdx.x >> 6), lane = threadIdx.x & 63;
    const float* src; int r;
    if (row < NTOK) { src = x + (size_t)row * D; r = row / SEQ; } else { src = ctx + (size_t)(row - NTOK) * D; r = 2; }
    float ss = 0.f;
    for (int i = 0; i < 8; ++i) { const float4 t = *(const float4*)(src + i * 256 + lane * 4); ss += t.x * t.x + t.y * t.y + t.z * t.z + t.w * t.w; }
    ss = wave_sum(ss); const float rstd = rsqrtf(ss / (float)D + EPS);
    const float* sh = mod + r * NMOD; const float* sc = sh + D;
    for (int i = 0; i < 8; ++i) { const int col = i * 256 + lane * 4; const float4 t = *(const float4*)(src + col);
        const float v[4] = {t.x, t.y, t.z, t.w}; bf16_t o[4];
#pragma unroll
        for (int j = 0; j < 4; ++j) o[j] = f2bf(v[j] * rstd * g1[col + j] * (1.f + sc[col + j]) + sh[col + j]);
        *(uint2*)(HX + (size_t)row * D + col) = make_uint2((unsigned)o[0] | ((unsigned)o[1] << 16), (unsigned)o[2] | ((unsigned)o[3] << 16)); }
}

template <bool BT, class FA, class FB, class FS>
__global__ __launch_bounds__(256) void gemm_naive(int M, int N, int K, int pad_, FA fa, FB fb, FS fs) {
    __shared__ float As[16][65], Bs[16][65];
    const int z = blockIdx.z, m0 = blockIdx.y * 64, n0 = blockIdx.x * 64, tx = threadIdx.x & 15, ty = threadIdx.x >> 4;
    float acc[4][4];
#pragma unroll
    for (int i = 0; i < 4; ++i)
#pragma unroll
        for (int j = 0; j < 4; ++j) acc[i][j] = 0.f;
    for (int k0 = 0; k0 < K; k0 += 16) {
#pragma unroll
        for (int i = 0; i < 4; ++i) { const int idx = threadIdx.x + i * 256, kk = idx & 15, mm = idx >> 4; As[kk][mm] = (m0 + mm < M) ? fa(z, m0 + mm, k0 + kk) : 0.f; }
#pragma unroll
        for (int i = 0; i < 4; ++i) { const int idx = threadIdx.x + i * 256; int kk, nn; if (BT) { kk = idx & 15; nn = idx >> 4; } else { nn = idx & 63; kk = idx >> 6; }
            Bs[kk][nn] = (n0 + nn < N) ? fb(z, k0 + kk, n0 + nn) : 0.f; }
        __syncthreads();
#pragma unroll
        for (int kk = 0; kk < 16; ++kk) { float a[4], b[4];
#pragma unroll
            for (int i = 0; i < 4; ++i) { a[i] = As[kk][ty * 4 + i]; b[i] = Bs[kk][tx * 4 + i]; }
#pragma unroll
            for (int i = 0; i < 4; ++i)
#pragma unroll
                for (int j = 0; j < 4; ++j) acc[i][j] += a[i] * b[j]; }
        __syncthreads();
    }
#pragma unroll
    for (int i = 0; i < 4; ++i)
#pragma unroll
        for (int j = 0; j < 4; ++j) { const int m = m0 + ty * 4 + i, n = n0 + tx * 4 + j; if (m < M && n < N) fs(z, m, n, acc[i][j]); }
}
struct LdBf { const bf16_t* p; size_t zs; int ld; int pad;
    __device__ float operator()(int z, int r, int c) const { return bf2f(p[z * zs + (size_t)r * ld + c]); } };
struct LdBfT { const bf16_t* p; size_t zs; int ld; int pad;
    __device__ float operator()(int z, int k, int n) const { return bf2f(p[z * zs + (size_t)n * ld + k]); } };
struct LdF { const float* p; size_t zs; int ld; int pad;
    __device__ float operator()(int z, int r, int c) const { return p[z * zs + (size_t)r * ld + c]; } };

struct StInproj { bf16_t *G, *QLb, *KVLb, *RK;
    __device__ void operator()(int, int m, int n, float v) const {
        if (n < 2048) { if (m < NTOK) G[(size_t)m * 2048 + n] = f2bf(v); }
        else if (n < 2816) { if (m < NTOK) QLb[(size_t)m * 768 + (n - 2048)] = f2bf(v); }
        else if (n < 3328) KVLb[(size_t)m * 512 + (n - 2816)] = f2bf(v);
        else RK[(size_t)m * 64 + (n - 3328)] = f2bf(v); } };
__global__ void k_rstd(const bf16_t* __restrict__ QLb, const bf16_t* __restrict__ KVLb, float* __restrict__ rq, float* __restrict__ rkv) {
    const int row = blockIdx.x * 256 + threadIdx.x; if (row >= NROW) return;
    if (row < NTOK) { float s = 0.f; for (int i = 0; i < 768; ++i) { const float v = bf2f(QLb[(size_t)row * 768 + i]); s += v * v; } rq[row] = rsqrtf(s / 768.f + EPS); }
    { float s = 0.f; for (int i = 0; i < 512; ++i) { const float v = bf2f(KVLb[(size_t)row * 512 + i]); s += v * v; } rkv[row] = rsqrtf(s / 512.f + EPS); }
}
struct StQ { bf16_t* Q; const float* rq; __device__ void operator()(int, int m, int n, float v) const { Q[(size_t)m * 1536 + n] = f2bf(v * rq[m]); } };
struct StKV { bf16_t *KN, *V; const float* rkv;
    __device__ void operator()(int, int m, int n, float v) const { const int h = n >> 8, j = n & 255; v *= rkv[m];
        if (j < 128) KN[(size_t)m * 1024 + h * 128 + j] = f2bf(v);
        else { int b, key; if (m < NTOK) { b = m >> 12; key = m & 4095; } else { b = (m - NTOK) >> 8; key = SEQ + ((m - NTOK) & 255); }
            V[((size_t)(b * NH + h) * NKEY + key) * HV + (j - 128)] = f2bf(v); } } };

__global__ void k_qkprep(const bf16_t* __restrict__ QRAW, const bf16_t* __restrict__ KNRAW, const bf16_t* __restrict__ RK, const float* __restrict__ gq, const float* __restrict__ gk,
                         bf16_t* __restrict__ Qf, bf16_t* __restrict__ Kf) {
    const int id = blockIdx.x * 256 + threadIdx.x;
    const int nq = NTOK * NH, nk = NROW * NH;
    if (id >= nq + nk) return;
    const bool isq = id < nq; const int it = isq ? id : id - nq; const int row = it >> 3, h = it & 7;
    const bf16_t* a = isq ? QRAW + (size_t)row * 1536 + h * 192 : KNRAW + (size_t)row * 1024 + h * 128;
    const bf16_t* r = isq ? a + 128 : RK + (size_t)row * 64;
    const float* g = isq ? gq : gk;
    float s = 0.f;
    for (int d = 0; d < 128; ++d) { const float v = bf2f(a[d]); s += v * v; }
    for (int d = 0; d < 64; ++d) { const float v = bf2f(r[d]); s += v * v; }
    const float rstd = rsqrtf(s / 192.f + EPS);
    int b, pos; const bool lat = row < NTOK;
    if (lat) { b = row >> 12; pos = row & 4095; } else { b = (row - NTOK) >> 8; pos = SEQ + ((row - NTOK) & 255); }
    bf16_t* o = isq ? Qf + ((size_t)(b * NH + h) * SEQ + pos) * HQK : Kf + ((size_t)(b * NH + h) * NKEY + pos) * HQK;
    for (int d = 0; d < 128; ++d) o[d] = f2bf(bf2f(a[d]) * rstd * g[d]);
    const int prow = (pos & 4095) >> 6, pcol = pos & 63;
    for (int e = 0; e < 64; ++e) {
        const float xe = bf2f(r[e]) * rstd * g[128 + e]; float outv = xe;
        if (lat) { const int ax = e >> 5, i = e & 31, f = i & 15; const float p = (float)(ax ? pcol : prow);
            const float inv = powf(10000.f, -(float)f / 16.f); const float ang = p * inv; const float cs = cosf(ang), sn = sinf(ang);
            if (i < 16) { const float x2 = bf2f(r[e + 16]) * rstd * g[128 + e + 16]; outv = xe * cs - x2 * sn; }
            else { const float x1 = bf2f(r[e - 16]) * rstd * g[128 + e - 16]; outv = x1 * sn + xe * cs; } }
        o[128 + e] = f2bf(outv); }
}

struct StF { float* p; size_t zs; int ld; int pad; __device__ void operator()(int z, int m, int n, float v) const { p[z * zs + (size_t)m * ld + n] = v; } };
__global__ void k_softmax(float* __restrict__ S) {
    const size_t row = (size_t)blockIdx.x * 4 + (threadIdx.x >> 6); const int lane = threadIdx.x & 63;
    float* p = S + row * NKEY; const float sc = 0.07216878364870323f;
    float mx = -1e30f; for (int i = lane; i < NKEY; i += 64) mx = fmaxf(mx, p[i] * sc); mx = wave_max(mx);
    float sum = 0.f; for (int i = lane; i < NKEY; i += 64) { const float e = expf(p[i] * sc - mx); p[i] = e; sum += e; } sum = wave_sum(sum);
    const float inv = 1.f / sum; for (int i = lane; i < NKEY; i += 64) p[i] *= inv;
}
struct StAtt { bf16_t* A; int b; int pad; __device__ void operator()(int z, int m, int n, float v) const { A[(size_t)(b * SEQ + m) * 1024 + z * 128 + n] = f2bf(v); } };

__global__ void k_dft1(const bf16_t* __restrict__ G, bf16_t* __restrict__ T1) {
    __shared__ float ct[64], st[64];
    if (threadIdx.x < 64) { ct[threadIdx.x] = cospif((float)threadIdx.x / 32.f); st[threadIdx.x] = sinpif((float)threadIdx.x / 32.f); }
    __syncthreads();
    const int col = blockIdx.x * 256 + threadIdx.x, orow = blockIdx.y, b = blockIdx.z, k1 = orow >> 6, n2 = orow & 63;
    float tr = 0.f, ti = 0.f;
    for (int n1 = 0; n1 < 64; ++n1) { const size_t ir = (size_t)(b * SEQ + 64 * n1 + n2) * 2048; const float zr = bf2f(G[ir + col]), zi = bf2f(G[ir + 1024 + col]);
        const int m = (n1 * k1) & 63; const float c = ct[m], s = st[m]; tr += zr * c + zi * s; ti += zi * c - zr * s; }
    const float x = (float)(n2 * k1) / 2048.f, c = cospif(x), s = sinpif(x);
    const size_t orw = (size_t)(b * SEQ + orow) * 2048;
    T1[orw + col] = f2bf(tr * c + ti * s); T1[orw + 1024 + col] = f2bf(ti * c - tr * s);
}
__global__ void k_dft2(const bf16_t* __restrict__ T1, bf16_t* __restrict__ Y) {
    __shared__ float ct[64], st[64];
    if (threadIdx.x < 64) { ct[threadIdx.x] = cospif((float)threadIdx.x / 32.f); st[threadIdx.x] = sinpif((float)threadIdx.x / 32.f); }
    __syncthreads();
    const int col = blockIdx.x * 256 + threadIdx.x, orow = blockIdx.y, b = blockIdx.z, k1 = orow & 63, k2 = orow >> 6;
    float acc = 0.f;
    for (int n2 = 0; n2 < 64; ++n2) { const size_t ir = (size_t)(b * SEQ + 64 * k1 + n2) * 2048; const int m = (n2 * k2) & 63;
        acc += bf2f(T1[ir + col]) * ct[m] + bf2f(T1[ir + 1024 + col]) * st[m]; }
    Y[(size_t)(b * SEQ + orow) * 1024 + col] = f2bf(acc * (1.f / 1024.f));
}
__global__ void k_mixnorm(const bf16_t* __restrict__ Y, const bf16_t* __restrict__ ATT, bf16_t* __restrict__ MIXA) {
    const int row = blockIdx.x * 4 + (threadIdx.x >> 6), lane = threadIdx.x & 63;
    float sf = 0.f, sa = 0.f;
    for (int i = lane; i < 1024; i += 64) { const float a = bf2f(Y[(size_t)row * 1024 + i]), c = bf2f(ATT[(size_t)row * 1024 + i]); sf += a * a; sa += c * c; }
    sf = wave_sum(sf); sa = wave_sum(sa);
    const float rf = rsqrtf(sf / 1024.f + EPS), ra = rsqrtf(sa / 1024.f + EPS);
    for (int i = lane; i < 1024; i += 64) { MIXA[(size_t)row * 2048 + i] = f2bf(bf2f(Y[(size_t)row * 1024 + i]) * rf); MIXA[(size_t)row * 2048 + 1024 + i] = f2bf(bf2f(ATT[(size_t)row * 1024 + i]) * ra); }
}
struct StOut { float* out; const float* x; const float* mod; __device__ void operator()(int, int m, int n, float v) const { const int b = m >> 12; out[(size_t)m * D + n] = x[(size_t)m * D + n] + mod[b * NMOD + 2 * D + n] * v; } };

__global__ void k_route(const float* __restrict__ xn, const float* __restrict__ g2, const float* __restrict__ mod, const float* __restrict__ wrg, const float* __restrict__ brg,
                        const float* __restrict__ wre, const float* __restrict__ bre, bf16_t* __restrict__ HM, int* __restrict__ cnt, int* __restrict__ toke, int* __restrict__ tokp,
                        int* __restrict__ sltok, float* __restrict__ slw) {
    __shared__ float hm[D]; __shared__ float red[4]; __shared__ float lg[72];
    const int t = blockIdx.x, b = t >> 12, tid = threadIdx.x;
    const float* src = xn + (size_t)t * D; float ss = 0.f;
    for (int k = tid; k < D; k += 256) { const float v = src[k]; ss += v * v; }
    ss = wave_sum(ss); if ((tid & 63) == 0) red[tid >> 6] = ss; __syncthreads();
    const float rstd = rsqrtf((red[0] + red[1] + red[2] + red[3]) / (float)D + EPS);
    const float* sh = mod + b * NMOD + 3 * D; const float* sc = mod + b * NMOD + 4 * D;
    for (int k = tid; k < D; k += 256) { const float v = src[k] * rstd * g2[k] * (1.f + sc[k]) + sh[k]; hm[k] = v; HM[(size_t)t * D + k] = f2bf(v); }
    __syncthreads();
    if (tid < 72) { float acc = 0.f;
        if (tid < 8) { for (int k = 0; k < D; ++k) acc += hm[k] * wrg[k * 8 + tid]; acc += brg[tid]; }
        else { const int j = tid - 8; for (int k = 0; k < D; ++k) acc += hm[k] * wre[k * 64 + j]; acc += bre[j]; }
        lg[tid] = acc; }
    __syncthreads();
    if (tid == 0) {
        int gi = 0; float gm = lg[0]; for (int j = 1; j < 8; ++j) if (lg[j] > gm) { gm = lg[j]; gi = j; }
        float gs = 0.f; for (int j = 0; j < 8; ++j) gs += expf(lg[j] - gm); const float gp = 1.f / gs;
        const float* el = lg + 8 + gi * 8;
        int i0 = 0; float m0 = el[0]; for (int j = 1; j < 8; ++j) if (el[j] > m0) { m0 = el[j]; i0 = j; }
        int i1 = -1; float m1 = -1e30f; for (int j = 0; j < 8; ++j) if (j != i0 && el[j] > m1) { m1 = el[j]; i1 = j; }
        const float r = expf(m1 - m0), p0 = 1.f / (1.f + r), p1 = r / (1.f + r);
        const int e0 = gi * 8 + i0, e1 = gi * 8 + i1;
        const int q0 = atomicAdd(&cnt[e0], 1), q1 = atomicAdd(&cnt[e1], 1);
        toke[t * 2] = e0; toke[t * 2 + 1] = e1; tokp[t * 2] = q0; tokp[t * 2 + 1] = q1;
        sltok[e0 * ECAP + q0] = t; sltok[e1 * ECAP + q1] = t; slw[e0 * ECAP + q0] = gp * p0; slw[e1 * ECAP + q1] = gp * p1; }
}

__global__ __launch_bounds__(256) void k_moe_up(const bf16_t* __restrict__ HM, const float* __restrict__ wg, const float* __restrict__ wu, const int* __restrict__ cnt, const int* __restrict__ sltok, bf16_t* __restrict__ H) {
    __shared__ float As[16][65], Bg[16][65], Bu[16][65]; __shared__ int toks[64];
    const int e = blockIdx.z, c = cnt[e], m0 = blockIdx.y * 64; if (m0 >= c) return;
    int base = 0; for (int i = 0; i < e; ++i) base += cnt[i];
    const int n0 = blockIdx.x * 64, tx = threadIdx.x & 15, ty = threadIdx.x >> 4;
    if (threadIdx.x < 64) toks[threadIdx.x] = (m0 + (int)threadIdx.x < c) ? sltok[e * ECAP + m0 + threadIdx.x] : -1;
    __syncthreads();
    const float* G = wg + (size_t)e * D * DE; const float* U = wu + (size_t)e * D * DE;
    float ag[4][4], au[4][4];
#pragma unroll
    for (int i = 0; i < 4; ++i)
#pragma unroll
        for (int j = 0; j < 4; ++j) { ag[i][j] = 0.f; au[i][j] = 0.f; }
    for (int k0 = 0; k0 < D; k0 += 16) {
#pragma unroll
        for (int i = 0; i < 4; ++i) { const int idx = threadIdx.x + i * 256, kk = idx & 15, mm = idx >> 4; const int tk = toks[mm]; As[kk][mm] = tk >= 0 ? bf2f(HM[(size_t)tk * D + k0 + kk]) : 0.f; }
#pragma unroll
        for (int i = 0; i < 4; ++i) { const int idx = threadIdx.x + i * 256, nn = idx & 63, kk = idx >> 6; Bg[kk][nn] = G[(size_t)(k0 + kk) * DE + n0 + nn]; Bu[kk][nn] = U[(size_t)(k0 + kk) * DE + n0 + nn]; }
        __syncthreads();
#pragma unroll
        for (int kk = 0; kk < 16; ++kk) { float a[4], bg[4], bu[4];
#pragma unroll
            for (int i = 0; i < 4; ++i) { a[i] = As[kk][ty * 4 + i]; bg[i] = Bg[kk][tx * 4 + i]; bu[i] = Bu[kk][tx * 4 + i]; }
#pragma unroll
            for (int i = 0; i < 4; ++i)
#pragma unroll
                for (int j = 0; j < 4; ++j) { ag[i][j] += a[i] * bg[j]; au[i][j] += a[i] * bu[j]; } }
        __syncthreads();
    }
#pragma unroll
    for (int i = 0; i < 4; ++i)
#pragma unroll
        for (int j = 0; j < 4; ++j) { const int m = m0 + ty * 4 + i, n = n0 + tx * 4 + j; if (m < c) { const float g = ag[i][j]; H[(size_t)(base + m) * DE + n] = f2bf(g / (1.f + expf(-g)) * au[i][j]); } }
}
__global__ __launch_bounds__(256) void k_moe_down(const bf16_t* __restrict__ H, const float* __restrict__ wd, const int* __restrict__ cnt, const float* __restrict__ slw, bf16_t* __restrict__ YS) {
    __shared__ float As[16][65], Bs[16][65];
    const int e = blockIdx.z, c = cnt[e], m0 = blockIdx.y * 64; if (m0 >= c) return;
    int base = 0; for (int i = 0; i < e; ++i) base += cnt[i];
    const int n0 = blockIdx.x * 64, tx = threadIdx.x & 15, ty = threadIdx.x >> 4;
    const float* W = wd + (size_t)e * DE * D;
    float acc[4][4];
#pragma unroll
    for (int i = 0; i < 4; ++i)
#pragma unroll
        for (int j = 0; j < 4; ++j) acc[i][j] = 0.f;
    for (int k0 = 0; k0 < DE; k0 += 16) {
#pragma unroll
        for (int i = 0; i < 4; ++i) { const int idx = threadIdx.x + i * 256, kk = idx & 15, mm = idx >> 4; As[kk][mm] = (m0 + mm < c) ? bf2f(H[(size_t)(base + m0 + mm) * DE + k0 + kk]) : 0.f; }
#pragma unroll
        for (int i = 0; i < 4; ++i) { const int idx = threadIdx.x + i * 256, nn = idx & 63, kk = idx >> 6; Bs[kk][nn] = W[(size_t)(k0 + kk) * D + n0 + nn]; }
        __syncthreads();
#pragma unroll
        for (int kk = 0; kk < 16; ++kk) { float a[4], b[4];
#pragma unroll
            for (int i = 0; i < 4; ++i) { a[i] = As[kk][ty * 4 + i]; b[i] = Bs[kk][tx * 4 + i]; }
#pragma unroll
            for (int i = 0; i < 4; ++i)
#pragma unroll
                for (int j = 0; j < 4; ++j) acc[i][j] += a[i] * b[j]; }
        __syncthreads();
    }
#pragma unroll
    for (int i = 0; i < 4; ++i)
#pragma unroll
        for (int j = 0; j < 4; ++j) { const int m = m0 + ty * 4 + i, n = n0 + tx * 4 + j; if (m < c) YS[(size_t)(base + m) * D + n] = f2bf(acc[i][j] * slw[e * ECAP + m]); }
}
__global__ void k_combine(float* __restrict__ out, const float* __restrict__ mod, const bf16_t* __restrict__ YS, const int* __restrict__ cnt, const int* __restrict__ toke, const int* __restrict__ tokp) {
    __shared__ int base[NEXP];
    if (threadIdx.x == 0) { int s = 0; for (int i = 0; i < NEXP; ++i) { base[i] = s; s += cnt[i]; } }
    __syncthreads();
    const int t = blockIdx.x, b = t >> 12;
    const int s0 = base[toke[t * 2]] + tokp[t * 2], s1 = base[toke[t * 2 + 1]] + tokp[t * 2 + 1];
    const float* gt = mod + b * NMOD + 5 * D;
    for (int n = threadIdx.x; n < D; n += 256) out[(size_t)t * D + n] += gt[n] * (bf2f(YS[(size_t)s0 * D + n]) + bf2f(YS[(size_t)s1 * D + n]));
}
}

extern "C" void kernel_launch(void* const* d_in, const int* in_sizes, int n_in, void* d_out, int out_size, void* d_ws, size_t ws_size, hipStream_t stream) {
    if (n_in != 25 || out_size != NTOK * D || ws_size < WS_END) { fprintf(stderr, "kernel_launch: unexpected shapes (n_in %d out %d ws %zu need %zu)\n", n_in, out_size, ws_size, (size_t)WS_END); return; }
    const float* x = (const float*)d_in[0]; const float* c = (const float*)d_in[1]; const float* ctx = (const float*)d_in[2]; const float* cctx = (const float*)d_in[3];
    const float* w_ada = (const float*)d_in[4]; const float* b_ada = (const float*)d_in[5]; const float* g1 = (const float*)d_in[6]; const float* g2 = (const float*)d_in[7];
    const float* w_in = (const float*)d_in[8]; const float* g_q_a = (const float*)d_in[9]; const float* g_kv_a = (const float*)d_in[10]; const float* w_uq = (const float*)d_in[11];
    const float* w_ukv = (const float*)d_in[12]; const float* g_qk_q = (const float*)d_in[13]; const float* g_qk_k = (const float*)d_in[14]; const float* g_of = (const float*)d_in[15];
    const float* g_oa = (const float*)d_in[16]; const float* w_out = (const float*)d_in[17]; const float* w_rg = (const float*)d_in[18]; const float* b_rg = (const float*)d_in[19];
    const float* w_re = (const float*)d_in[20]; const float* b_re = (const float*)d_in[21]; const float* w_gate = (const float*)d_in[22]; const float* w_up = (const float*)d_in[23];
    const float* w_down = (const float*)d_in[24];
    float* out = (float*)d_out; char* ws = (char*)d_ws;
    int* CNT = (int*)(ws + WS_CTL); float* MOD = (float*)(ws + WS_MOD);
    bf16_t* WinT = (bf16_t*)(ws + WS_WINT); bf16_t* WuqT = (bf16_t*)(ws + WS_WUQT); bf16_t* WukvT = (bf16_t*)(ws + WS_WUKVT); bf16_t* WoutT = (bf16_t*)(ws + WS_WOUTT);
    bf16_t* HX = (bf16_t*)(ws + WS_HX); bf16_t* G = (bf16_t*)(ws + WS_G); bf16_t* QLb = (bf16_t*)(ws + WS_QL); bf16_t* KVLb = (bf16_t*)(ws + WS_KVL); bf16_t* RK = (bf16_t*)(ws + WS_ROPEK);
    float* RSTDQ = (float*)(ws + WS_RSTDQ); float* RSTDKV = (float*)(ws + WS_RSTDKV);
    bf16_t* QRAW = (bf16_t*)(ws + WS_QRAW); bf16_t* KNRAW = (bf16_t*)(ws + WS_KNRAW); bf16_t* Vf = (bf16_t*)(ws + WS_VF); bf16_t* Qf = (bf16_t*)(ws + WS_QF); bf16_t* Kf = (bf16_t*)(ws + WS_KF);
    bf16_t* ATT = (bf16_t*)(ws + WS_ATT); bf16_t* T1 = (bf16_t*)(ws + WS_T1); bf16_t* Y = (bf16_t*)(ws + WS_Y); bf16_t* MIXA = (bf16_t*)(ws + WS_MIXA); bf16_t* HM = (bf16_t*)(ws + WS_HM);
    int* TOKE = (int*)(ws + WS_TOKE); int* TOKP = (int*)(ws + WS_TOKP); int* SLTOK = (int*)(ws + WS_SLTOK); float* SLW = (float*)(ws + WS_SLW);
    bf16_t* H = (bf16_t*)(ws + WS_H); bf16_t* YS = (bf16_t*)(ws + WS_YS); float* SC = (float*)(ws + WS_SC);

    (void)hipMemsetAsync(ws + WS_CTL, 0, 65536, stream);
    (void)hipMemsetAsync(WinT + (size_t)3392 * D, 0, (size_t)192 * D * 2, stream);
    k_ada<<<dim3(NMOD / 256, 3), 256, 0, stream>>>(c, cctx, w_ada, b_ada, MOD);
    k_fold<<<2048, 256, 0, stream>>>(w_in, WinT);
    k_tcvt<<<dim3(1344 / 32, D / 32), 256, 0, stream>>>(w_in, nullptr, nullptr, WinT + (size_t)2048 * D, INP, 1024, D, 1344, 0, D);
    k_tcvt<<<dim3(1536 / 32, 768 / 32), 256, 0, stream>>>(w_uq, g_q_a, g_q_a, WuqT, 1536, 0, 768, 1536, 768, 768);
    k_tcvt<<<dim3(2048 / 32, 512 / 32), 256, 0, stream>>>(w_ukv, g_kv_a, g_kv_a, WukvT, 2048, 0, 512, 2048, 512, 512);
    k_tcvt<<<dim3(2048 / 32, 2048 / 32), 256, 0, stream>>>(w_out, g_of, g_oa, WoutT, 2048, 0, 2048, 2048, 1024, 2048);
    k_hx<<<NROW / 4, 256, 0, stream>>>(x, ctx, g1, MOD, HX);
    gemm_naive<true><<<dim3(3392 / 64, NROW / 64, 1), 256, 0, stream>>>(NROW, 3392, D, 0, LdBf{HX, 0, D}, LdBfT{WinT, 0, D}, StInproj{G, QLb, KVLb, RK});
    k_rstd<<<NROW / 256, 256, 0, stream>>>(QLb, KVLb, RSTDQ, RSTDKV);
    gemm_naive<true><<<dim3(1536 / 64, NTOK / 64, 1), 256, 0, stream>>>(NTOK, 1536, 768, 0, LdBf{QLb, 0, 768}, LdBfT{WuqT, 0, 768}, StQ{QRAW, RSTDQ});
    gemm_naive<true><<<dim3(2048 / 64, NROW / 64, 1), 256, 0, stream>>>(NROW, 2048, 512, 0, LdBf{KVLb, 0, 512}, LdBfT{WukvT, 0, 512}, StKV{KNRAW, Vf, RSTDKV});
    k_qkprep<<<(NTOK * NH + NROW * NH + 255) / 256, 256, 0, stream>>>(QRAW, KNRAW, RK, g_qk_q, g_qk_k, Qf, Kf);
    for (int b = 0; b < 2; ++b) {
        gemm_naive<true><<<dim3(NKEY / 64, SEQ / 64, NH), 256, 0, stream>>>(SEQ, NKEY, HQK, 0, LdBf{Qf + (size_t)b * NH * SEQ * HQK, (size_t)SEQ * HQK, HQK}, LdBfT{Kf + (size_t)b * NH * NKEY * HQK, (size_t)NKEY * HQK, HQK}, StF{SC, (size_t)SEQ * NKEY, NKEY});
        k_softmax<<<NH * SEQ / 4, 256, 0, stream>>>(SC);
        gemm_naive<false><<<dim3(HV / 64, SEQ / 64, NH), 256, 0, stream>>>(SEQ, HV, NKEY, 0, LdF{SC, (size_t)SEQ * NKEY, NKEY}, LdBf{Vf + (size_t)b * NH * NKEY * HV, (size_t)NKEY * HV, HV}, StAtt{ATT, b});
    }
    k_dft1<<<dim3(4, SEQ, 2), 256, 0, stream>>>(G, T1);
    k_dft2<<<dim3(4, SEQ, 2), 256, 0, stream>>>(T1, Y);
    k_mixnorm<<<NTOK / 4, 256, 0, stream>>>(Y, ATT, MIXA);
    gemm_naive<true><<<dim3(D / 64, NTOK / 64, 1), 256, 0, stream>>>(NTOK, D, 2048, 0, LdBf{MIXA, 0, 2048}, LdBfT{WoutT, 0, 2048}, StOut{out, x, MOD});
    k_route<<<NTOK, 256, 0, stream>>>(out, g2, MOD, w_rg, b_rg, w_re, b_re, HM, CNT, TOKE, TOKP, SLTOK, SLW);
    k_moe_up<<<dim3(DE / 64, ECAP / 64, NEXP), 256, 0, stream>>>(HM, w_gate, w_up, CNT, SLTOK, H);
    k_moe_down<<<dim3(D / 64, ECAP / 64, NEXP), 256, 0, stream>>>(H, w_down, CNT, SLW, YS);
    k_combine<<<NTOK, 256, 0, stream>>>(out, MOD, YS, CNT, TOKE, TOKP);
}
```

```cpp
#include <hip/hip_runtime.h>
#include <stdint.h>
#include <stdio.h>

typedef unsigned short bf16_t;
namespace pg8 {
#define PG8_LAS __attribute__((address_space(3)))
typedef short bf16x8 __attribute__((ext_vector_type(8)));
typedef float f32x4 __attribute__((ext_vector_type(4)));
typedef unsigned u32x4 __attribute__((ext_vector_type(4)));
constexpr int BM = 256, BK = 64, HALF = 128, HTB = HALF * BK * 2  , STAGE_BYTES = 8 * HTB, NXCD = 8, WGM = 8;

__host__ __device__ __forceinline__ int lds_byte(int r, int c) { const int st = (r >> 4) * 2 + (c >> 5), rr = r & 15, cc = c & 31, ob = rr * 64 + cc * 2; return st * 1024 + (ob ^ (((ob >> 9) & 1) << 5)); }
__host__ __device__ __forceinline__ void stage_rc(int b, int& R, int& C) { const int st = b / 1024, sb = b % 1024, swz = sb ^ (((sb >> 9) & 1) << 5); R = (st >> 1) * 16 + swz / 64; C = (st & 1) * 32 + (swz % 64) / 2; }
__host__ __device__ __forceinline__ int perm32(int rho) { const int n = rho >> 4, i = rho & 15; return 8 * (i >> 2) + 4 * n + (i & 3); }

struct Unit { int pm, pn; };
struct Gemm { const bf16_t* A; const bf16_t* Bt; int M, N, K, lda, ldb, pad; };

__device__ __forceinline__ unsigned cvt_pk_bf16(float lo, float hi) { unsigned r; asm volatile("v_cvt_pk_bf16_f32 %0, %1, %2" : "=v"(r) : "v"(lo), "v"(hi)); return r; }
struct OrdGrid {
    int nM, nN, G, c;
    __device__ bool next(int i, Unit& u) const {
        const int nwg = nM * nN; const long L = (long)i * G + c; if (L >= nwg) return false;
        int wgid = (int)L; { const int q = nwg / NXCD, r = nwg % NXCD, xcd = wgid % NXCD, off = wgid / NXCD; wgid = (xcd < r ? xcd * (q + 1) : r * (q + 1) + (xcd - r) * q) + off; }
        const int nig = WGM * nN, gid = wgid / nig, fm = gid * WGM, gsz = (nM - fm) < WGM ? (nM - fm) : WGM;
        u.pm = fm + ((wgid % nig) % gsz); u.pn = (wgid % nig) / gsz; return true; }
    __device__ __forceinline__ void a_ready(const Unit&) const {}
    __device__ __forceinline__ void done(const Unit&) const {}
};
struct OrdInproj {
    int G, c;
    __device__ bool next(int i, Unit& u) const {
        const int L = i * G + c; if (L >= 454) return false;
        if (L >= 448) { const int e = L - 448; u.pm = 32 + e / 3; u.pn = 11 + e % 3; return true; }
        const int wgid = (L % NXCD) * 56 + L / NXCD, nig = WGM * 14, gid = wgid / nig;
        u.pm = gid * WGM + ((wgid % nig) % WGM); u.pn = (wgid % nig) / WGM; return true; }
    __device__ __forceinline__ void a_ready(const Unit&) const {}
    __device__ __forceinline__ void done(const Unit&) const {}
};
struct OrdKV {
    int c;
    __device__ bool next(int i, Unit& u) const {
        int L;
        if (c >= 192) { if (i >= 2) return false; L = 2 * (c - 192) + i; }
        else { if (i >= 1 || c >= 144) return false; L = 128 + c; }
        u.pm = L >> 3; u.pn = L & 7; return true; }
    __device__ __forceinline__ void a_ready(const Unit&) const {}
    __device__ __forceinline__ void done(const Unit&) const {}
};
struct EpiInproj { static constexpr bool PERM = true, AFTER_DRAIN = false;
    bf16_t *G, *QLb, *KVLb, *RK; float* SSQP;
    __device__ __forceinline__ void operator()(const f32x4 (&acc)[2][2][4][2], const Unit& u, int wr, int wc, int fr, int fq) const {
        const int pn = u.pn; bf16_t* base; int ldc, colt, sq = -1;
        if (pn < 8) { base = G; ldc = 2048; colt = pn * 256; }
        else if (pn < 11) { base = QLb; ldc = 768; colt = (pn - 8) * 256; sq = (pn - 8) * 4 + wc; }
        else if (pn < 13) { base = KVLb; ldc = 512; colt = (pn - 11) * 256; sq = (pn - 8) * 4 + wc; }
        else { base = RK; ldc = 64; colt = 0; }
        const int row0 = u.pm * BM + wr * 64 + fr, col0 = colt + wc * 32 + 8 * fq;
#pragma unroll
        for (int ai = 0; ai < 2; ++ai)
#pragma unroll
            for (int m = 0; m < 4; ++m) { const int row = row0 + ai * HALF + m * 16; float s = 0.f;
#pragma unroll
                for (int bj = 0; bj < 2; ++bj) { const f32x4 v0 = acc[ai][bj][m][0], v1 = acc[ai][bj][m][1];
                    u32x4 w; w.x = cvt_pk_bf16(v0[0], v0[1]); w.y = cvt_pk_bf16(v0[2], v0[3]); w.z = cvt_pk_bf16(v1[0], v1[1]); w.w = cvt_pk_bf16(v1[2], v1[3]);
                    if (pn < 13 || (bj == 0 && wc < 2)) *(u32x4*)(base + (size_t)row * ldc + col0 + bj * HALF) = w;
                    s += (v0[0] * v0[0] + v0[1] * v0[1]) + (v0[2] * v0[2] + v0[3] * v0[3]) + (v1[0] * v1[0] + v1[1] * v1[1]) + (v1[2] * v1[2] + v1[3] * v1[3]); }
                if (sq >= 0) { s += __shfl_xor(s, 16); s += __shfl_xor(s, 32); if (fq == 0) SSQP[(size_t)row * 20 + sq] = s; } }
    }
};
struct EpiQ { static constexpr bool PERM = true, AFTER_DRAIN = false;
    bf16_t* Q; const float* SSQP;
    __device__ __forceinline__ void operator()(const f32x4 (&acc)[2][2][4][2], const Unit& u, int wr, int wc, int fr, int fq) const {
        const int row0 = u.pm * BM + wr * 64 + fr, col0 = u.pn * BM + wc * 32 + 8 * fq;
#pragma unroll
        for (int ai = 0; ai < 2; ++ai)
#pragma unroll
            for (int m = 0; m < 4; ++m) { const int row = row0 + ai * HALF + m * 16; const f32x4* sp = (const f32x4*)(SSQP + (size_t)row * 20);
                const f32x4 a = sp[0], b = sp[1], c = sp[2]; const float s = ((a[0] + a[1]) + (a[2] + a[3])) + ((b[0] + b[1]) + (b[2] + b[3])) + ((c[0] + c[1]) + (c[2] + c[3]));
                const float rs = rsqrtf(s * (1.f / 768.f) + 1e-6f);
#pragma unroll
                for (int bj = 0; bj < 2; ++bj) { const f32x4 v0 = acc[ai][bj][m][0] * rs, v1 = acc[ai][bj][m][1] * rs;
                    u32x4 w; w.x = cvt_pk_bf16(v0[0], v0[1]); w.y = cvt_pk_bf16(v0[2], v0[3]); w.z = cvt_pk_bf16(v1[0], v1[1]); w.w = cvt_pk_bf16(v1[2], v1[3]);
                    *(u32x4*)(Q + (size_t)row * 1536 + col0 + bj * HALF) = w; } }
    }
};
struct EpiKV { static constexpr bool PERM = true, AFTER_DRAIN = false;
    bf16_t *KN, *V; const float* SSQP;
    __device__ __forceinline__ void operator()(const f32x4 (&acc)[2][2][4][2], const Unit& u, int wr, int wc, int fr, int fq) const {
        const int row0 = u.pm * BM + wr * 64 + fr, h = u.pn, cw = wc * 32 + 8 * fq;
#pragma unroll
        for (int ai = 0; ai < 2; ++ai)
#pragma unroll
            for (int m = 0; m < 4; ++m) { const int row = row0 + ai * HALF + m * 16; const f32x4* sp = (const f32x4*)(SSQP + (size_t)row * 20 + 12);
                const f32x4 a = sp[0], b = sp[1]; const float s = ((a[0] + a[1]) + (a[2] + a[3])) + ((b[0] + b[1]) + (b[2] + b[3]));
                const float rs = rsqrtf(s * (1.f / 512.f) + 1e-6f);
                int bb, key; if (row < 8192) { bb = row >> 12; key = row & 4095; } else { bb = (row - 8192) >> 8; key = 4096 + ((row - 8192) & 255); }
#pragma unroll
                for (int bj = 0; bj < 2; ++bj) { const f32x4 v0 = acc[ai][bj][m][0] * rs, v1 = acc[ai][bj][m][1] * rs;
                    u32x4 w; w.x = cvt_pk_bf16(v0[0], v0[1]); w.y = cvt_pk_bf16(v0[2], v0[3]); w.z = cvt_pk_bf16(v1[0], v1[1]); w.w = cvt_pk_bf16(v1[2], v1[3]);
                    if (bj == 0) *(u32x4*)(KN + (size_t)row * 1024 + h * 128 + cw) = w;
                    else *(u32x4*)(V + ((size_t)(bb * 8 + h) * 4352 + key) * 128 + cw) = w; } }
    }
};

struct OrdOne {
    int pm, pn;
    __device__ bool next(int i, Unit& u) const { if (i) return false; u.pm = pm; u.pn = pn; return true; }
    __device__ __forceinline__ void a_ready(const Unit&) const {}
    __device__ __forceinline__ void done(const Unit&) const {}
};
struct EpiFold { static constexpr bool PERM = true, AFTER_DRAIN = false;
    bf16_t* W; int g, pad;
    __device__ __forceinline__ void operator()(const f32x4 (&acc)[2][2][4][2], const Unit& u, int wr, int wc, int fr, int fq) const {
        const int r0 = wr * 64 + fr, col0 = u.pn * BM + wc * 32 + 8 * fq;
#pragma unroll
        for (int ai = 0; ai < 2; ++ai)
#pragma unroll
            for (int m = 0; m < 4; ++m) { const int kc = r0 + ai * HALF + m * 16; bf16_t* rowp = W + (size_t)(u.pm * 1024 + g * 256 + kc) * 2048 + col0;
#pragma unroll
                for (int bj = 0; bj < 2; ++bj) { const f32x4 v0 = acc[ai][bj][m][0], v1 = acc[ai][bj][m][1];
                    u32x4 w; w.x = cvt_pk_bf16(v0[0], v0[1]); w.y = cvt_pk_bf16(v0[2], v0[3]); w.z = cvt_pk_bf16(v1[0], v1[1]); w.w = cvt_pk_bf16(v1[2], v1[3]);
                    *(u32x4*)(rowp + bj * HALF) = w; } }
    }
};
struct EpiOut { static constexpr bool PERM = false, AFTER_DRAIN = false;
    float* out; const float* x; const float* mod;
    __device__ __forceinline__ void operator()(const f32x4 (&acc)[2][2][4][2], const Unit& u, int wr, int wc, int fr, int fq) const {
        const int row0 = u.pm * BM + wr * 64 + fr, col0 = u.pn * BM + wc * 32 + 4 * fq; const float* gt = mod + (u.pm >> 4) * 12288 + 4096;
        f32x4 gv[2][2];
#pragma unroll
        for (int bj = 0; bj < 2; ++bj)
#pragma unroll
            for (int n = 0; n < 2; ++n) gv[bj][n] = *(const f32x4*)(gt + col0 + bj * HALF + n * 16);
        f32x4 xa[4], xb[4];
#define EPO_LOAD(X, g_) do { const size_t off_ = (size_t)(row0 + ((g_) >> 2) * HALF + ((g_) & 3) * 16) * 2048 + col0; \
            _Pragma("unroll") for (int q_ = 0; q_ < 4; ++q_) X[q_] = *(const f32x4*)(x + off_ + (q_ >> 1) * HALF + (q_ & 1) * 16); } while (0)
#define EPO_STORE(X, g_) do { const size_t off_ = (size_t)(row0 + ((g_) >> 2) * HALF + ((g_) & 3) * 16) * 2048 + col0; \
            _Pragma("unroll") for (int q_ = 0; q_ < 4; ++q_) *(f32x4*)(out + off_ + (q_ >> 1) * HALF + (q_ & 1) * 16) = X[q_] + gv[q_ >> 1][q_ & 1] * acc[(g_) >> 2][q_ >> 1][(g_) & 3][q_ & 1]; } while (0)
        EPO_LOAD(xa, 0);
#pragma unroll
        for (int g = 0; g < 8; g += 2) {
            EPO_LOAD(xb, g + 1); __builtin_amdgcn_sched_barrier(0);
            EPO_STORE(xa, g); __builtin_amdgcn_sched_barrier(0);
            if (g + 2 < 8) { EPO_LOAD(xa, g + 2); } __builtin_amdgcn_sched_barrier(0);
            EPO_STORE(xb, g + 1); __builtin_amdgcn_sched_barrier(0);
        }
#undef EPO_LOAD
#undef EPO_STORE
    }
};
template <class Epi, class Sched, bool STAMP = false>
__device__ __forceinline__ void gemm_phase(PG8_LAS unsigned char* lds, const Gemm g, const Sched& S, const Epi& E, unsigned long long* stamps) {
    const int tid = threadIdx.x, wid = __builtin_amdgcn_readfirstlane(tid >> 6), lane = tid & 63, wr = wid >> 2, wc = wid & 3, fr = lane & 15, fq = lane >> 4;
    const int K = g.K, nt = K / BK;
    int ts_lo = 0, ts_hi = 0, nts = 0; const unsigned long long rt_entry = STAMP ? (unsigned long long)wall_clock64() : 0ull;
#define PG8_STAMP() do { if (STAMP && wid == 0 && nts < 64) { const unsigned long long _c = (unsigned long long)clock64(); \
        ts_lo = (lane == nts) ? (int)(unsigned)_c : ts_lo; ts_hi = (lane == nts) ? (int)(unsigned)(_c >> 32) : ts_hi; ++nts; } } while (0)
    PG8_STAMP();
    unsigned voffA[2], voffB[2];
#pragma unroll
    for (int i = 0; i < 2; ++i) { int R, C; stage_rc(tid * 16 + i * 8192, R, C); const int Rb = Epi::PERM ? ((R & ~31) + perm32(R & 31)) : R;
        voffA[i] = (unsigned)(R * g.lda + C) * 2u; voffB[i] = (unsigned)(Rb * g.ldb + C) * 2u; }
    const size_t kstep = (size_t)(BK * 2);
    const size_t hstepA = (size_t)HALF * g.lda * 2, hstepB = (size_t)HALF * g.ldb * 2;
    const size_t tstepA = 2 * hstepA, tstepB = 2 * hstepB;
    const unsigned ldsw = (unsigned)wid * 1024u;
    const int aoff = lds_byte(wr * 64 + fr, fq * 8), boff = lds_byte(wc * 32 + fr, fq * 8);
#define PG8_SA(b, h) (((b) * 2 + (h)) * HTB)
#define PG8_SB(b, h) ((4 + (b) * 2 + (h)) * HTB)
#define PG8_STAGE(bufoff, gbase, voff) do { _Pragma("unroll") for (int _i = 0; _i < 2; ++_i) \
        __builtin_amdgcn_global_load_lds((const unsigned*)((const char*)(gbase) + (voff)[_i]), (PG8_LAS unsigned*)(lds + (bufoff) + ldsw + _i * 8192), 16, 0, 0); } while (0)
#define PG8_LDA(dst, b, h) do { _Pragma("unroll") for (int m = 0; m < 4; ++m) _Pragma("unroll") for (int k = 0; k < 2; ++k) dst[m][k] = *(const PG8_LAS bf16x8*)(lds + PG8_SA(b, h) + aoff + m * 2048 + k * 1024); } while (0)
#define PG8_LDB(dst, b, h) do { _Pragma("unroll") for (int n = 0; n < 2; ++n) _Pragma("unroll") for (int k = 0; k < 2; ++k) dst[n][k] = *(const PG8_LAS bf16x8*)(lds + PG8_SB(b, h) + boff + n * 2048 + k * 1024); } while (0)
#define PG8_MMA(ai, bj, At, Bt) do { __builtin_amdgcn_s_setprio(1); _Pragma("unroll") for (int m = 0; m < 4; ++m) _Pragma("unroll") for (int n = 0; n < 2; ++n) _Pragma("unroll") for (int k = 0; k < 2; ++k) \
        acc[ai][bj][m][n] = __builtin_amdgcn_mfma_f32_16x16x32_bf16(Bt[n][k], At[m][k], acc[ai][bj][m][n], 0, 0, 0); __builtin_amdgcn_s_setprio(0); } while (0)
#define PG8_WAIT_V(n) asm volatile("s_waitcnt vmcnt(" #n ")" ::: "memory")
#define PG8_WAIT_L(n) asm volatile("s_waitcnt lgkmcnt(" #n ")" ::: "memory")
#define PG8_BAR __builtin_amdgcn_s_barrier()
#define PG8_SCHED __builtin_amdgcn_sched_barrier(0)
    Unit cur, nxt; int ui = 0;
    if (!S.next(0, cur)) return;
    f32x4 acc[2][2][4][2];
#pragma unroll
    for (int a = 0; a < 2; ++a)
#pragma unroll
        for (int b = 0; b < 2; ++b)
#pragma unroll
            for (int m = 0; m < 4; ++m)
#pragma unroll
                for (int n = 0; n < 2; ++n) acc[a][b][m][n] = (f32x4){0.f, 0.f, 0.f, 0.f};
    bf16x8 At[4][2], B0[2][2], B1[2][2];
    const char* cA = (const char*)g.A + (size_t)cur.pm * tstepA; const char* cB = (const char*)g.Bt + (size_t)cur.pn * tstepB;
    S.a_ready(cur);
    PG8_STAGE(PG8_SB(0, 0), cB, voffB); PG8_STAGE(PG8_SA(0, 0), cA, voffA); PG8_STAGE(PG8_SB(0, 1), cB + hstepB, voffB); PG8_STAGE(PG8_SA(0, 1), cA + hstepA, voffA);
    if (wr == 1) PG8_BAR;
    PG8_WAIT_V(4); PG8_BAR;
    PG8_STAGE(PG8_SB(1, 0), cB + kstep, voffB); PG8_STAGE(PG8_SA(1, 0), cA + kstep, voffA); PG8_STAGE(PG8_SB(1, 1), cB + hstepB + kstep, voffB);
    PG8_WAIT_V(6); PG8_BAR;
    PG8_STAMP();
    for (;;) {
        const bool has_next = S.next(ui + 1, nxt);
        const char* nA = has_next ? (const char*)g.A + (size_t)nxt.pm * tstepA : cA; const char* nB = has_next ? (const char*)g.Bt + (size_t)nxt.pn * tstepB : cB;
        for (int t = 0; t < nt; t += 2) {
            const bool last = (t == nt - 2);
            const char* a1 = cA + (size_t)(t + 1) * kstep;
            const char* a2 = last ? nA : cA + (size_t)(t + 2) * kstep; const char* b2 = last ? nB : cB + (size_t)(t + 2) * kstep;
            const char* a3 = a2 + kstep; const char* b3 = b2 + kstep;
            if (last && has_next) S.a_ready(nxt);
            PG8_LDB(B0, 0, 0); PG8_SCHED; PG8_LDA(At, 0, 0); PG8_STAGE(PG8_SA(1, 1), a1 + hstepA, voffA);
            PG8_WAIT_L(8); PG8_BAR; PG8_WAIT_L(0); PG8_MMA(0, 0, At, B0); PG8_BAR; PG8_SCHED;
            PG8_LDB(B1, 0, 1); PG8_STAGE(PG8_SB(0, 0), b2, voffB);
            PG8_BAR; PG8_WAIT_L(0); PG8_MMA(0, 1, At, B1); PG8_BAR;
            PG8_LDA(At, 0, 1); PG8_STAGE(PG8_SA(0, 0), a2, voffA);
            PG8_BAR; PG8_WAIT_L(0); PG8_MMA(1, 0, At, B0); PG8_BAR; PG8_SCHED;
            PG8_STAGE(PG8_SB(0, 1), b2 + hstepB, voffB);
            PG8_WAIT_V(6); PG8_BAR; PG8_MMA(1, 1, At, B1); PG8_BAR;
            PG8_LDB(B0, 1, 0); PG8_SCHED; PG8_LDA(At, 1, 0); PG8_STAGE(PG8_SA(0, 1), a2 + hstepA, voffA);
            PG8_WAIT_L(8); PG8_BAR; PG8_WAIT_L(0); PG8_MMA(0, 0, At, B0); PG8_BAR; PG8_SCHED;
            PG8_LDB(B1, 1, 1); PG8_STAGE(PG8_SB(1, 0), b3, voffB);
            PG8_BAR; PG8_WAIT_L(0); PG8_MMA(0, 1, At, B1); PG8_BAR;
            PG8_LDA(At, 1, 1); PG8_STAGE(PG8_SA(1, 0), a3, voffA);
            PG8_BAR; PG8_WAIT_L(0); PG8_MMA(1, 0, At, B0); PG8_BAR; PG8_SCHED;
            PG8_STAGE(PG8_SB(1, 1), b3 + hstepB, voffB);
            PG8_WAIT_V(6); PG8_BAR; PG8_MMA(1, 1, At, B1); PG8_BAR;
        }
        PG8_STAMP();
        if constexpr (!Epi::AFTER_DRAIN) { E(acc, cur, wr, wc, fr, fq); S.done(cur); }
        PG8_STAMP();
        if (!has_next) break;
#pragma unroll
        for (int a = 0; a < 2; ++a)
#pragma unroll
            for (int b = 0; b < 2; ++b)
#pragma unroll
                for (int m = 0; m < 4; ++m)
#pragma unroll
                    for (int n = 0; n < 2; ++n) acc[a][b][m][n] = (f32x4){0.f, 0.f, 0.f, 0.f};
        cur = nxt; cA = nA; cB = nB; ++ui;
    }
    PG8_WAIT_V(0);
    if (wr == 0) PG8_BAR;
    PG8_BAR;
    if constexpr (Epi::AFTER_DRAIN) { E.fused(acc, cur, wr, wc, fr, fq, lds, wid, lane); S.done(cur); }
    PG8_STAMP();
    if (STAMP && wid == 0) { stamps[lane] = lane < nts ? (((unsigned long long)(unsigned)ts_hi << 32) | (unsigned)ts_lo) : 0ull;
        if (lane == 62) stamps[62] = rt_entry; if (lane == 63) stamps[63] = (unsigned long long)wall_clock64(); }
#undef PG8_STAMP
#undef PG8_SA
#undef PG8_SB
#undef PG8_STAGE
#undef PG8_LDA
#undef PG8_LDB
#undef PG8_MMA
#undef PG8_WAIT_V
#undef PG8_WAIT_L
#undef PG8_BAR
#undef PG8_SCHED
}
}

namespace att {
using u32x4s = __attribute__((ext_vector_type(4))) unsigned;
using bf16x8 = __attribute__((ext_vector_type(8))) short;
using s16x4  = __attribute__((ext_vector_type(4))) short;
using f32x16 = __attribute__((ext_vector_type(16))) float;
using u32x4  = __attribute__((ext_vector_type(4))) unsigned;
constexpr int DQ = 192, DV = 128, NW = 8, QBLK = 32, KVBLK = 64, KROW = 400  ;
constexpr float SCALE = 0.07216878364870323f;
constexpr float THR = 8.f;
constexpr int SHM_V = KVBLK * DV * 2, SHM_K = KVBLK * KROW, SHM_QX = 2 * SHM_V + 2 * SHM_K + NW * 64 * 4, SHM_ATTN = SHM_QX + NW * 4096;
#define ATT_SBAR() __builtin_amdgcn_sched_barrier(0)
__device__ __forceinline__ int crow(int r, int hi) { return (r & 3) + 8 * (r >> 2) + 4 * hi; }
__device__ __forceinline__ unsigned cvtpk(float lo, float hi) { unsigned r; asm volatile("v_cvt_pk_bf16_f32 %0, %1, %2" : "=v"(r) : "v"(lo), "v"(hi)); return r; }
__device__ __forceinline__ void partialSM(f32x16& p0, f32x16& p1, float& m_reg, float& mn, float& alpha) {
  constexpr float C = SCALE * 1.4426950408889634f;
  float pmax = p0[0];
#pragma unroll
  for (int r = 1; r < 16; ++r) pmax = fmaxf(pmax, p0[r]);
#pragma unroll
  for (int r = 0; r < 16; ++r) pmax = fmaxf(pmax, p1[r]);
  { auto rr = __builtin_amdgcn_permlane32_swap(__float_as_uint(pmax), __float_as_uint(pmax), false, false);
    pmax = fmaxf(__uint_as_float(rr[0]), __uint_as_float(rr[1])); }
  if (__builtin_expect(__all(pmax - m_reg <= THR / SCALE), 1)) { mn = m_reg; alpha = 1.f; }
  else { mn = fmaxf(m_reg, pmax); alpha = __builtin_amdgcn_exp2f((m_reg - mn) * C); m_reg = mn; }
  const float mnC = -mn * C;
#pragma unroll
  for (int r = 0; r < 16; ++r) p0[r] = fmaf(p0[r], C, mnC);
#pragma unroll
  for (int r = 0; r < 16; ++r) p1[r] = fmaf(p1[r], C, mnC);
#pragma unroll
  for (int r = 0; r < 16; ++r) p0[r] = __builtin_amdgcn_exp2f(p0[r]);
}
__device__ __forceinline__ void finishSM(f32x16& p0, f32x16& p1, float alpha, float& l_reg, bf16x8& pa0, bf16x8& pa1, bf16x8& pa2, bf16x8& pa3) {
#pragma unroll
  for (int r = 0; r < 16; ++r) p1[r] = __builtin_amdgcn_exp2f(p1[r]);
  float ps = 0;
#pragma unroll
  for (int r = 0; r < 16; ++r) ps += p0[r];
#pragma unroll
  for (int r = 0; r < 16; ++r) ps += p1[r];
  { auto rr = __builtin_amdgcn_permlane32_swap(__float_as_uint(ps), __float_as_uint(ps), false, false);
    ps = __uint_as_float(rr[0]) + __uint_as_float(rr[1]); }
  l_reg = l_reg * alpha + ps;
#define ATT_PK4(P, BASE, OUT) do { unsigned a0 = cvtpk(P[BASE + 0], P[BASE + 1]), a1 = cvtpk(P[BASE + 2], P[BASE + 3]);   \
    unsigned b0 = cvtpk(P[BASE + 4], P[BASE + 5]), b1 = cvtpk(P[BASE + 6], P[BASE + 7]);                              \
    auto r0 = __builtin_amdgcn_permlane32_swap(a0, b0, false, false); auto r1 = __builtin_amdgcn_permlane32_swap(a1, b1, false, false); \
    u32x4 w = {r0[0], r1[0], r0[1], r1[1]}; OUT = *reinterpret_cast<bf16x8*>(&w); } while (0)
  ATT_PK4(p0, 0, pa0); ATT_PK4(p0, 8, pa1); ATT_PK4(p1, 0, pa2); ATT_PK4(p1, 8, pa3);
#undef ATT_PK4
}
__device__ __forceinline__ void qkt(f32x16& p0, f32x16& p1, const char* Ks, const bf16x8* qr, const char* qx, int r32, int hi) {
  p0 = f32x16{}; p1 = f32x16{};
#pragma unroll
  for (int d0 = 0; d0 < 12; ++d0) { const int cb = (d0 * 16 + hi * 8) * 2;
    const bf16x8 b0 = *reinterpret_cast<const bf16x8*>(Ks + r32 * KROW + cb);
    const bf16x8 b1 = *reinterpret_cast<const bf16x8*>(Ks + (32 + r32) * KROW + cb);
    const bf16x8 q = d0 < 8 ? qr[d0] : *reinterpret_cast<const bf16x8*>(qx + (d0 - 8) * 1024);
    p0 = __builtin_amdgcn_mfma_f32_32x32x16_bf16(b0, q, p0, 0, 0, 0);
    p1 = __builtin_amdgcn_mfma_f32_32x32x16_bf16(b1, q, p1, 0, 0, 0); }
}
__device__ __forceinline__ int v_st(int k, int c) { const int kk = (k & ~0xC) | ((k & 4) << 1) | ((k & 8) >> 1); return ((kk >> 3) * 4 + (c >> 5)) * 512 + ((kk & 7) * 32 + (c & 31)) * 2; }
__device__ __forceinline__ int v_rd_base(int lane) { return ((lane & 3) << 3) | (((lane >> 2) & 3) << 6) | (((lane >> 4) & 1) << 5) | (((lane >> 5) & 1) << 8); }
constexpr int v_rd_off(int d0, int ks, int half) { return d0 * 512 + ks * 4096 + half * 2048; }
template <int OFF> __device__ __forceinline__ s16x4 tr_read(int vb) {
  s16x4 r; asm volatile("ds_read_b64_tr_b16 %0, %1 offset:%2" : "=&v"(r) : "v"(vb), "i"(OFF) : "memory"); return r;
}
template <int D0> __device__ __forceinline__ void pv_one(f32x16& od, int vb, bf16x8 pa0, bf16x8 pa1, bf16x8 pa2, bf16x8 pa3) {
  const s16x4 l0 = tr_read<v_rd_off(D0, 0, 0)>(vb), h0 = tr_read<v_rd_off(D0, 0, 1)>(vb), l1 = tr_read<v_rd_off(D0, 1, 0)>(vb), h1 = tr_read<v_rd_off(D0, 1, 1)>(vb);
  const s16x4 l2 = tr_read<v_rd_off(D0, 2, 0)>(vb), h2 = tr_read<v_rd_off(D0, 2, 1)>(vb), l3 = tr_read<v_rd_off(D0, 3, 0)>(vb), h3 = tr_read<v_rd_off(D0, 3, 1)>(vb);
  asm volatile("s_waitcnt lgkmcnt(0)" ::: "memory"); ATT_SBAR();
#define ATT_PK(L, H) (bf16x8){L[0], L[1], L[2], L[3], H[0], H[1], H[2], H[3]}
  od = __builtin_amdgcn_mfma_f32_32x32x16_bf16(pa0, ATT_PK(l0, h0), od, 0, 0, 0);
  od = __builtin_amdgcn_mfma_f32_32x32x16_bf16(pa1, ATT_PK(l1, h1), od, 0, 0, 0);
  od = __builtin_amdgcn_mfma_f32_32x32x16_bf16(pa2, ATT_PK(l2, h2), od, 0, 0, 0);
  od = __builtin_amdgcn_mfma_f32_32x32x16_bf16(pa3, ATT_PK(l3, h3), od, 0, 0, 0);
#undef ATT_PK
}
__device__ __forceinline__ void pv_d0(f32x16* o, int vb, bf16x8 pa0, bf16x8 pa1, bf16x8 pa2, bf16x8 pa3) {
  pv_one<0>(o[0], vb, pa0, pa1, pa2, pa3); pv_one<1>(o[1], vb, pa0, pa1, pa2, pa3); pv_one<2>(o[2], vb, pa0, pa1, pa2, pa3); pv_one<3>(o[3], vb, pa0, pa1, pa2, pa3);
}
struct SideJob { const float* wg; const float* wu; unsigned char* w8; int s0, n; };
__device__ __forceinline__ void attn_body(const bf16_t* __restrict__ Qb, const bf16_t* __restrict__ Kh, const bf16_t* __restrict__ Vh, bf16_t* __restrict__ Ob, int ldo, int seq, char* lds, const SideJob sj) {
  const int tid = threadIdx.x, wid = tid >> 6, lane = tid & 63, r32 = lane & 31, hi = lane >> 5;
  char* V_lds = lds; char* K_lds = lds + 2 * SHM_V;
  float* ws = (float*)(lds + 2 * SHM_V + 2 * SHM_K) + wid * 64; float* li_l = ws; float* al_l = ws + 32;
  float m_reg = -1e30f, l_reg = 0; f32x16 o[4] = {}; bf16x8 qr[8];
  const bf16_t* Qw = Qb + (long)(wid * QBLK + r32) * DQ + hi * 8;
#pragma unroll
  for (int d0 = 0; d0 < 8; ++d0) qr[d0] = *reinterpret_cast<const bf16x8*>(Qw + d0 * 16);
  char* qx = lds + SHM_QX + wid * 4096 + lane * 16;
#pragma unroll
  for (int d0 = 8; d0 < 12; ++d0) *reinterpret_cast<bf16x8*>(qx + (d0 - 8) * 1024) = *reinterpret_cast<const bf16x8*>(Qw + d0 * 16);
  const int sr = tid >> 4, sc = (tid & 15) * 8, vst0 = v_st(sr, sc), vst1 = v_st(32 + sr, sc);
  const int kr = tid >> 3, kc = (tid & 7) * 8;
  const int kst = kr * KROW + kc * 2;
  const int vb0 = (int)(uintptr_t)V_lds + v_rd_base(lane);
  bf16x8 vs0, vs1, ks0, ks1, ks2;
#define ATT_SLOAD(k0) do { vs0 = *reinterpret_cast<const bf16x8*>(&Vh[(long)((k0) + sr) * DV + sc]); vs1 = *reinterpret_cast<const bf16x8*>(&Vh[(long)((k0) + 32 + sr) * DV + sc]); \
    const bf16_t* kp_ = &Kh[(long)((k0) + kr) * DQ + kc]; ks0 = *reinterpret_cast<const bf16x8*>(kp_); ks1 = *reinterpret_cast<const bf16x8*>(kp_ + 64); ks2 = *reinterpret_cast<const bf16x8*>(kp_ + 128); } while (0)
#define ATT_SWRITE(b) do { *(bf16x8*)(V_lds + (b) * SHM_V + vst0) = vs0; *(bf16x8*)(V_lds + (b) * SHM_V + vst1) = vs1; \
    *(bf16x8*)(K_lds + (b) * SHM_K + kst) = ks0; *(bf16x8*)(K_lds + (b) * SHM_K + kst + 128) = ks1; *(bf16x8*)(K_lds + (b) * SHM_K + kst + 256) = ks2; } while (0)
#define ATT_SWAIT() asm volatile("s_waitcnt vmcnt(0)" ::: "memory")
#define ATT_RESC(a) do { if (__any((a) < 1.f)) { if (hi == 0) al_l[r32] = (a); asm volatile("s_waitcnt lgkmcnt(0)" ::: "memory"); \
    _Pragma("unroll") for (int d = 0; d < 4; ++d) _Pragma("unroll") for (int r = 0; r < 16; ++r) o[d][r] *= al_l[crow(r, hi)]; } } while (0)
  f32x16 p0, p1; float mn, al; bf16x8 pa0, pa1, pa2, pa3; const int NT = seq / KVBLK;
  ATT_SLOAD(0); ATT_SWAIT(); ATT_SWRITE(0); __syncthreads();
  ATT_SLOAD(KVBLK);
  u32x4 sw[4] = {}; const int s_half = __builtin_amdgcn_readfirstlane(tid >> 8), s_ng = tid & 15, s_kq = (tid & 255) >> 4;
#define ATT_SIDE_LOAD(jj_) do { const int s_ = sj.s0 + (jj_); if (s_ < sj.n) { const int uid_ = s_ >> 5, t_ = s_ & 31, e_ = uid_ / 12, jc_ = uid_ - e_ * 12; \
      const float* wp_ = (s_half ? sj.wu : sj.wg) + (size_t)e_ * (2048 * 768) + (size_t)(64 * t_ + 4 * s_kq) * 768 + jc_ * 64 + 4 * s_ng; \
      _Pragma("unroll") for (int q_ = 0; q_ < 4; ++q_) sw[q_] = *(const u32x4*)(wp_ + q_ * 768); } } while (0)
#define ATT_SIDE_STORE(jj_) do { const int s_ = sj.s0 + (jj_); if (s_ < sj.n) { u32x4 w_; \
      _Pragma("unroll") for (int i_ = 0; i_ < 4; ++i_) { int p_ = __builtin_amdgcn_cvt_pk_fp8_f32(__uint_as_float(sw[0][i_]), __uint_as_float(sw[1][i_]), 0, false); \
          p_ = __builtin_amdgcn_cvt_pk_fp8_f32(__uint_as_float(sw[2][i_]), __uint_as_float(sw[3][i_]), p_, true); w_[i_] = (unsigned)p_; } \
      *(u32x4*)(sj.w8 + ((size_t)s_ * 512 + tid) * 16) = w_; } } while (0)
  for (int j = 0; j < NT; ++j) {
    const int buf = j & 1;
    ATT_SBAR(); qkt(p0, p1, K_lds + buf * SHM_K, qr, qx, r32, hi);
    partialSM(p0, p1, m_reg, mn, al);
    ATT_RESC(al);
    finishSM(p0, p1, al, l_reg, pa0, pa1, pa2, pa3); ATT_SBAR();
    ATT_SWAIT();
    if (j + 1 < NT) { ATT_SWRITE(buf ^ 1); }
    if (j > 0) ATT_SIDE_STORE(j - 1);
    if (j + 2 < NT) ATT_SLOAD((j + 2) * KVBLK);
    ATT_SIDE_LOAD(j);
    ATT_SBAR();
    pv_d0(o, vb0 + buf * SHM_V, pa0, pa1, pa2, pa3);
    __syncthreads();
  }
  ATT_SWAIT(); ATT_SIDE_STORE(NT - 1);
#undef ATT_SIDE_LOAD
#undef ATT_SIDE_STORE
  if (hi == 0) li_l[r32] = l_reg; asm volatile("s_waitcnt lgkmcnt(0)" ::: "memory");
  float rli[16];
#pragma unroll
  for (int r = 0; r < 16; ++r) rli[r] = __builtin_amdgcn_rcpf(li_l[crow(r, hi)]);
  bf16_t* Ow = Ob + (long)(wid * QBLK) * ldo;
#pragma unroll
  for (int r = 0; r < 16; ++r) { const int orow = crow(r, hi);
#pragma unroll
    for (int d0 = 0; d0 < 4; ++d0) Ow[(long)orow * ldo + d0 * 32 + r32] = (bf16_t)(cvtpk(o[d0][r] * rli[r], 0.f) & 0xffffu); }
  __syncthreads();
#undef ATT_SLOAD
#undef ATT_SWRITE
#undef ATT_SWAIT
#undef ATT_RESC
}
}

namespace moe {
using bf16x8 = __attribute__((ext_vector_type(8))) short;
using f32x4 = __attribute__((ext_vector_type(4))) float;
using u32x4 = __attribute__((ext_vector_type(4))) unsigned;
constexpr int TM = 384, A_BYTES = TM * 128, B_BYTES = 128 * 128;
#define MOE_AUX 0
constexpr int LDS_A = 0, LDS_B = 2 * A_BYTES, LDS_ROW = LDS_B + 2 * B_BYTES, LDS_BASE = LDS_ROW + TM * 4, LDS_BYTES = LDS_BASE + 64 * 4;
__device__ __forceinline__ unsigned cvtpk(float lo, float hi) { unsigned r; asm volatile("v_cvt_pk_bf16_f32 %0, %1, %2" : "=v"(r) : "v"(lo), "v"(hi)); return r; }

template <int MODE, int NM, int PROBE, bool PRE>
__device__ __forceinline__ void moe_pass(const __amdgpu_buffer_rsrc_t rsA, const __amdgpu_buffer_rsrc_t rsB, const float* __restrict__ slw_e, void* __restrict__ Outv,
                                         int rows, int orow0, int ncol0, int rot, int wid, int lane, unsigned boff, int bwb, int brd, const int* rowidx, char* lds) {
    constexpr int K = MODE == 0 ? 2048 : 768, NK = K / 64, LDW = MODE == 0 ? 768 : 2048, APITCH = MODE == 0 ? 2176 : 768, BB = 128 * 64;
    const int fr = lane & 15, fq = lane >> 4;
    unsigned aoff[NM];
#pragma unroll
    for (int mi = 0; mi < NM; ++mi) aoff[mi] = (unsigned)rowidx[(wid + 8 * mi) * 16 + fr] * (unsigned)APITCH + (unsigned)fq * 16u;
    f32x4 accg[NM][4], accu[NM][4];
#pragma unroll
    for (int mi = 0; mi < NM; ++mi)
#pragma unroll
        for (int nt = 0; nt < 4; ++nt) { accg[mi][nt] = (f32x4){0.f, 0.f, 0.f, 0.f}; accu[mi][nt] = (f32x4){0.f, 0.f, 0.f, 0.f}; }
    u32x4 aA[NM] = {}, aB[NM] = {}, rb0[4] = {}, rb1[4] = {};
#define KS(t_) ((((t_) + rot) % NK) * 64)
#define MOE_LOADA(AF, k0) do { if (!(PROBE & 1)) { _Pragma("unroll") for (int mi = 0; mi < NM; ++mi) AF[mi] = __builtin_amdgcn_raw_buffer_load_b128(rsA, aoff[mi], (k0), 0); } } while (0)
#define MOE_LOADB(RB, k0) do { if (!(PROBE & 2)) { if (PRE) RB[0] = __builtin_amdgcn_raw_buffer_load_b128(rsB, boff, ((k0) >> 6) * 8192, 0); else { _Pragma("unroll") for (int jj = 0; jj < 4; ++jj) RB[jj] = __builtin_amdgcn_raw_buffer_load_b128(rsB, boff, ((k0) + jj) * (LDW * 4), 0); } } } while (0)
#define MOE_WRITEB(RB, buf) do { _Pragma("unroll") for (int i = 0; i < 4; ++i) { int p_; if (PRE) p_ = (int)RB[0][i]; else { p_ = __builtin_amdgcn_cvt_pk_fp8_f32(__uint_as_float(RB[0][i]), __uint_as_float(RB[1][i]), 0, false); \
        p_ = __builtin_amdgcn_cvt_pk_fp8_f32(__uint_as_float(RB[2][i]), __uint_as_float(RB[3][i]), p_, true); } *(int*)(lds + (buf) * BB + bwb + i * 64) = p_; } } while (0)
#define MOE_LO(v) ((long)(((unsigned long long)(v)[1] << 32) | (unsigned long long)(v)[0]))
#define MOE_HI(v) ((long)(((unsigned long long)(v)[3] << 32) | (unsigned long long)(v)[2]))
#define MOE_COMPUTE(buf, AF) do { if (PROBE & 4) break; u32x4 bq[8]; \
        _Pragma("unroll") for (int nt = 0; nt < 8; ++nt) bq[nt] = *(const u32x4*)(lds + (buf) * BB + brd + nt * 1024); \
        _Pragma("unroll") for (int nt = 0; nt < 4; ++nt) { \
            _Pragma("unroll") for (int mi = 0; mi < NM; ++mi) { accg[mi][nt] = __builtin_amdgcn_mfma_f32_16x16x32_fp8_fp8(MOE_LO(bq[nt]), MOE_LO(AF[mi]), accg[mi][nt], 0, 0, 0); accu[mi][nt] = __builtin_amdgcn_mfma_f32_16x16x32_fp8_fp8(MOE_LO(bq[4 + nt]), MOE_LO(AF[mi]), accu[mi][nt], 0, 0, 0); } \
            _Pragma("unroll") for (int mi = 0; mi < NM; ++mi) { accg[mi][nt] = __builtin_amdgcn_mfma_f32_16x16x32_fp8_fp8(MOE_HI(bq[nt]), MOE_HI(AF[mi]), accg[mi][nt], 0, 0, 0); accu[mi][nt] = __builtin_amdgcn_mfma_f32_16x16x32_fp8_fp8(MOE_HI(bq[4 + nt]), MOE_HI(AF[mi]), accu[mi][nt], 0, 0, 0); } } } while (0)
    MOE_LOADA(aA, KS(0)); MOE_LOADB(rb0, KS(0)); MOE_LOADB(rb1, KS(1));
    MOE_WRITEB(rb0, 0);
    __syncthreads();
    for (int t = 0; t < NK; t += 2) {
        MOE_LOADA(aB, KS(t + 1)); MOE_LOADB(rb0, KS(t + 2));
        MOE_COMPUTE(0, aA);
        MOE_WRITEB(rb1, 1);
        __syncthreads();
        MOE_LOADA(aA, KS(t + 2)); MOE_LOADB(rb1, KS(t + 3));
        MOE_COMPUTE(1, aB);
        MOE_WRITEB(rb0, 0);
        __syncthreads();
    }
#undef KS
#undef MOE_LOADA
#undef MOE_LOADB
#undef MOE_WRITEB
#undef MOE_LO
#undef MOE_HI
#undef MOE_COMPUTE
    asm volatile("s_waitcnt vmcnt(0)" ::: "memory");
    { int laneE = lane; asm volatile("" : "+v"(laneE)); const int frE = laneE & 15, fqE = laneE >> 4;
#pragma unroll
      for (int mi = 0; mi < NM; ++mi) { const int m = (wid + 8 * mi) * 16 + frE;
        if (m < rows && (PROBE == 0 || accg[mi][0][0] == 12345.678f)) {
            if (MODE == 0) { unsigned char* op = (unsigned char*)Outv + (size_t)(orow0 + m) * 768 + ncol0 + 4 * fqE;
#pragma unroll
                for (int nt = 0; nt < 4; ++nt) { f32x4 h;
#pragma unroll
                    for (int r = 0; r < 4; ++r) { const float g = accg[mi][nt][r]; h[r] = g / (1.f + __expf(-g)) * accu[mi][nt][r]; }
                    int p_ = __builtin_amdgcn_cvt_pk_fp8_f32(h[0], h[1], 0, false); p_ = __builtin_amdgcn_cvt_pk_fp8_f32(h[2], h[3], p_, true); *(int*)(op + nt * 16) = p_; } }
            else { bf16_t* op = (bf16_t*)Outv + (size_t)(orow0 + m) * 2048 + ncol0 + 4 * fqE; const float w = slw_e[m];
#pragma unroll
                for (int nt = 0; nt < 4; ++nt) { const f32x4 a = accg[mi][nt] * w, b = accu[mi][nt] * w;
                    uint2 w0_, w1_; w0_.x = cvtpk(a[0], a[1]); w0_.y = cvtpk(a[2], a[3]); w1_.x = cvtpk(b[0], b[1]); w1_.y = cvtpk(b[2], b[3]);
                    *(uint2*)(op + nt * 16) = w0_; *(uint2*)(op + 64 + nt * 16) = w1_; } } } } }
}
template <int MODE, int PROBE = 0>
__device__ __forceinline__ void moe_unit(const unsigned char* __restrict__ Asrc, const int* __restrict__ sltok_e, const float* __restrict__ slw_e,
                                         const float* __restrict__ W0, const float* __restrict__ W1, void* __restrict__ Outv, int cnt, int base, int ncol0, int rot, char* lds, const unsigned char* w8u) {
    constexpr int K = MODE == 0 ? 2048 : 768, LDW = MODE == 0 ? 768 : 2048;
    int tid = threadIdx.x; asm volatile("" : "+v"(tid));
    const int wid = __builtin_amdgcn_readfirstlane(tid >> 6), lane = tid & 63, fr = lane & 15, fq = lane >> 4;
    int* rowidx = (int*)(lds + LDS_ROW);
    const int half = tid >> 8, tq = tid & 255, ng = tq & 15, kq = tq >> 4;
    const int halfu = wid >> 2;
    const __amdgpu_buffer_rsrc_t rsB = __builtin_amdgcn_make_buffer_rsrc((void*)(halfu ? W1 : W0), (short)0, K * LDW * 4, 0x00020000);
    const __amdgpu_buffer_rsrc_t rsA = __builtin_amdgcn_make_buffer_rsrc((void*)Asrc, (short)0, MODE == 0 ? 8192 * 2176 : 16384 * 768, 0x00020000);
    const unsigned boff = (unsigned)((4 * kq) * LDW + 4 * ng) * 4u;
    const int bwb = LDS_B + (half * 64 + 4 * ng) * 64 + (((kq >> 2) ^ (ng & 3)) << 4) + (kq & 3) * 4;
    const int brd = LDS_B + fr * 64 + ((fq ^ ((fr >> 2) & 3)) << 4);
    for (int m0 = 0; m0 < cnt; m0 += TM) {
        const int rows = (cnt - m0) < TM ? (cnt - m0) : TM;
        __syncthreads();
        if (tid < TM) { const int m = m0 + tid < cnt ? m0 + tid : cnt - 1; rowidx[tid] = MODE == 0 ? sltok_e[m] : base + m; }
        __syncthreads();
        if (MODE == 0 && w8u != nullptr) {
            const __amdgpu_buffer_rsrc_t rs8 = __builtin_amdgcn_make_buffer_rsrc((void*)w8u, (short)0, 32 * 8192, 0x00020000); const unsigned off8 = (unsigned)tid * 16u;
            if (rows <= 256) moe_pass<MODE, 2, PROBE, true>(rsA, rs8, slw_e + m0, Outv, rows, base + m0, ncol0, rot, wid, lane, off8, bwb, brd, rowidx, lds);
            else             moe_pass<MODE, 3, PROBE, true>(rsA, rs8, slw_e + m0, Outv, rows, base + m0, ncol0, rot, wid, lane, off8, bwb, brd, rowidx, lds);
        } else {
            if (rows <= 256) moe_pass<MODE, 2, PROBE, false>(rsA, rsB, slw_e + m0, Outv, rows, base + m0, ncol0, rot, wid, lane, boff, bwb, brd, rowidx, lds);
            else             moe_pass<MODE, 3, PROBE, false>(rsA, rsB, slw_e + m0, Outv, rows, base + m0, ncol0, rot, wid, lane, boff, bwb, brd, rowidx, lds);
        }
    }
}
template <int MODE, int PROBE = 0>
__device__ __forceinline__ void moe_phase(const unsigned char* Asrc, const int* sltok, const float* slw, const float* Wa, const float* Wb, void* Out, const int* cntg, char* lds, int c, int G, const unsigned char* w8 = nullptr) {
    constexpr int NT = MODE == 0 ? 12 : 16;
    int* basel = (int*)(lds + LDS_BASE);
    __syncthreads();
    if (threadIdx.x < 64) { int s = 0; for (int i = 0; i < (int)threadIdx.x; ++i) s += cntg[i * 64]; basel[threadIdx.x] = s; }
    __syncthreads();
    const bool xl = (G == 256);
    const int nu = xl ? 8 * NT : 64 * NT;
    for (int idx = xl ? (c >> 3) : c; idx < nu; idx += xl ? 32 : G) {
        int e, j; if (xl) { e = (c & 7) + 8 * (idx / NT); j = idx % NT; } else { e = idx / NT; j = idx % NT; }
        const int cnt = cntg[e * 64], base = basel[e];
        if (cnt <= 0) continue;
        if (MODE == 0) moe_unit<0, PROBE>(Asrc, sltok + (size_t)e * 8192, nullptr, Wa + (size_t)e * 2048 * 768 + j * 64, Wb + (size_t)e * 2048 * 768 + j * 64, Out, cnt, base, j * 64, (j * 8 + e) % 32, lds, (w8 != nullptr && G == 256 && e * 12 + j < 544) ? w8 + (size_t)(e * 12 + j) * (32 * 8192) : nullptr);
        else moe_unit<1, PROBE>(Asrc, nullptr, slw + (size_t)e * 8192, Wa + (size_t)e * 768 * 2048 + j * 128, Wa + (size_t)e * 768 * 2048 + j * 128 + 64, Out, cnt, base, j * 128, (j * 3 + e) % 12, lds, nullptr);
    }
}
}

namespace {
constexpr int D = 2048, SEQ = 4096, NTOK = 8192, NCTX = 512, NROW = 8704;
constexpr int NH = 8, HQK = 192, HV = 128, NKEY = 4352;
constexpr int INP = 2368, NMOD = 12288;
constexpr int NEXP = 64, DE = 768, ECAP = 8192;
constexpr int HMLD = 2176;
constexpr int WIN_ROWS = 3584;
constexpr float EPS = 1e-6f;

__device__ __forceinline__ float bf2f(bf16_t b) { return __uint_as_float(((unsigned)b) << 16); }
__device__ __forceinline__ bf16_t f2bf(float f) { unsigned u = __float_as_uint(f); u += 0x7FFFu + ((u >> 16) & 1u); return (bf16_t)(u >> 16); }
__device__ __forceinline__ float wave_sum(float v) { for (int o = 32; o >= 1; o >>= 1) v += __shfl_xor(v, o); return v; }
__device__ __forceinline__ float wave_max(float v) { for (int o = 32; o >= 1; o >>= 1) v = fmaxf(v, __shfl_xor(v, o)); return v; }

constexpr size_t al256(size_t x) { return (x + 255) / 256 * 256; }
constexpr size_t WS_CTL   = 0;
constexpr size_t WS_MOD   = 65536;
constexpr size_t WS_WINT  = WS_MOD   + al256((size_t)3 * NMOD * 4);
constexpr size_t WS_WUQT  = WS_WINT  + al256((size_t)WIN_ROWS * D * 2);
constexpr size_t WS_WUKVT = WS_WUQT  + al256((size_t)1536 * 768 * 2);
constexpr size_t WS_WOUTT = WS_WUKVT + al256((size_t)2048 * 512 * 2);
constexpr size_t WS_HX    = WS_WOUTT + al256((size_t)2048 * 2048 * 2);
constexpr size_t WS_G     = WS_HX    + al256((size_t)NROW * D * 2);
constexpr size_t WS_QL    = WS_G     + al256((size_t)NTOK * 2048 * 2);
constexpr size_t WS_KVL   = WS_QL    + al256((size_t)NTOK * 768 * 2);
constexpr size_t WS_ROPEK = WS_KVL   + al256((size_t)NROW * 512 * 2);
constexpr size_t WS_RSTDQ = WS_ROPEK + al256((size_t)NROW * 64 * 2);
constexpr size_t WS_RSTDKV= WS_RSTDQ + al256((size_t)NROW * 4);
constexpr size_t WS_QRAW  = WS_RSTDKV+ al256((size_t)NROW * 4);
constexpr size_t WS_KNRAW = WS_QRAW  + al256((size_t)NTOK * 1536 * 2);
constexpr size_t WS_VF    = WS_KNRAW + al256((size_t)NROW * 1024 * 2);
constexpr size_t WS_QF    = WS_VF    + al256((size_t)2 * NH * NKEY * HV * 2);
constexpr size_t WS_KF    = WS_QF    + al256((size_t)2 * NH * SEQ * HQK * 2);
constexpr size_t WS_ATT   = WS_KF    + al256((size_t)2 * NH * NKEY * HQK * 2);
constexpr size_t WS_T1    = WS_ATT   + al256((size_t)NTOK * 1024 * 2);
constexpr size_t WS_Y     = WS_T1    + al256((size_t)NTOK * 2048 * 2);
constexpr size_t WS_MIXA  = WS_Y     + al256((size_t)NTOK * 1024 * 2);
constexpr size_t WS_HM    = WS_MIXA  + al256((size_t)NTOK * 2048 * 2);
constexpr size_t WS_TOKE  = WS_HM    + al256((size_t)NTOK * HMLD * 2);
constexpr size_t WS_TOKP  = WS_TOKE  + al256((size_t)NTOK * 2 * 4);
constexpr size_t WS_SLTOK = WS_TOKP  + al256((size_t)NTOK * 2 * 4);
constexpr size_t WS_SLW   = WS_SLTOK + al256((size_t)NEXP * ECAP * 4);
constexpr size_t WS_H     = WS_SLW   + al256((size_t)NEXP * ECAP * 4);
constexpr size_t WS_YS    = WS_H     + al256((size_t)16384 * DE * 2);
constexpr size_t WS_SSQP  = WS_YS    + al256((size_t)16384 * D * 2);
constexpr size_t WS_WF    = WS_SSQP  + al256((size_t)NROW * 20 * 4);
constexpr size_t WS_MT    = WS_WF    + al256((size_t)2048 * 1024 * 2);
constexpr size_t WS_WR    = WS_MT    + al256((size_t)512 * 256 * 2);
constexpr size_t WS_WRH   = WS_WR    + al256((size_t)2048 * 96 * 4);
constexpr size_t WS_WRL   = WS_WRH   + al256((size_t)80 * 2048 * 2);
constexpr size_t WS_AB    = WS_WRL   + al256((size_t)80 * 2048 * 2);
constexpr size_t WS_SHW   = WS_AB    + al256((size_t)2 * 2048 * 4);
constexpr size_t WS_SC    = WS_SHW   + al256((size_t)2 * 96 * 4);
constexpr size_t WS_END   = WS_SC    + al256((size_t)NH * SEQ * NKEY * 4);

__global__ void k_ada(const float* __restrict__ c, const float* __restrict__ cctx, const float* __restrict__ w, const float* __restrict__ b, float* __restrict__ mod) {
    __shared__ float sc[D];
    const int n = blockIdx.x * 256 + threadIdx.x, r = blockIdx.y;
    const float* cond = r < 2 ? c + r * D : cctx;
    for (int k = threadIdx.x; k < D; k += 256) { const float v = cond[k]; sc[k] = v / (1.f + expf(-v)); }
    __syncthreads();
    float acc = 0.f;
    for (int k = 0; k < D; ++k) acc += sc[k] * w[(size_t)k * NMOD + n];
    mod[r * NMOD + n] = acc + b[n];
}

__global__ void k_fold(const float* __restrict__ w_in, bf16_t* __restrict__ WinT) {
    __shared__ float tab[256];
    const int j = blockIdx.x, im = j >> 10, g = (j >> 8) & 3, kc = j & 255;
    { const int c = threadIdx.x, m = (c * kc) & 255; const float x = (float)m / 128.f; tab[c] = im ? -sinpif(x) : cospif(x); }
    __syncthreads();
    for (int k = threadIdx.x; k < D; k += 256) {
        const float* wr = w_in + (size_t)k * INP + g * 256; float acc = 0.f;
        for (int c = 0; c < 256; ++c) acc += wr[c] * tab[c];
        WinT[(size_t)j * D + k] = f2bf(acc);
    }
}

__global__ void k_tcvt(const float* __restrict__ in, const float* __restrict__ s0, const float* __restrict__ s1, bf16_t* __restrict__ out, int ldin, int coff, int K, int N, int ssplit, int ldo) {
    __shared__ float t[32][33];
    const int k0 = blockIdx.y * 32, n0 = blockIdx.x * 32, tx = threadIdx.x & 31, ty = threadIdx.x >> 5;
    for (int i = ty; i < 32; i += 8) { const int k = k0 + i, n = n0 + tx; float v = 0.f;
        if (k < K && n < N) { v = in[(size_t)k * ldin + coff + n]; if (s0) v *= (k < ssplit ? s0[k] : s1[k - ssplit]); }
        t[i][tx] = v; }
    __syncthreads();
    for (int i = ty; i < 32; i += 8) { const int n = n0 + i, k = k0 + tx; if (n < N && k < K) out[(size_t)n * ldo + k] = f2bf(t[tx][i]); }
}

__global__ void k_hx(const float* __restrict__ x, const float* __restrict__ ctx, const float* __restrict__ g1, const float* __restrict__ mod, bf16_t* __restrict__ HX) {
    const int row = blockIdx.x * 4 + (threadIdx.x >> 6), lane = threadIdx.x & 63;
    const float* src; int r;
    if (row < NTOK) { src = x + (size_t)row * D; r = row / SEQ; } else { src = ctx + (size_t)(row - NTOK) * D; r = 2; }
    float ss = 0.f;
    for (int i = 0; i < 8; ++i) { const float4 t = *(const float4*)(src + i * 256 + lane * 4); ss += t.x * t.x + t.y * t.y + t.z * t.z + t.w * t.w; }
    ss = wave_sum(ss); const float rstd = rsqrtf(ss / (float)D + EPS);
    const float* sh = mod + r * NMOD; const float* sc = sh + D;
    for (int i = 0; i < 8; ++i) { const int col = i * 256 + lane * 4; const float4 t = *(const float4*)(src + col);
        const float v[4] = {t.x, t.y, t.z, t.w}; bf16_t o[4];
#pragma unroll
        for (int j = 0; j < 4; ++j) o[j] = f2bf(v[j] * rstd * g1[col + j] * (1.f + sc[col + j]) + sh[col + j]);
        *(uint2*)(HX + (size_t)row * D + col) = make_uint2((unsigned)o[0] | ((unsigned)o[1] << 16), (unsigned)o[2] | ((unsigned)o[3] << 16)); }
}

template <bool BT, class FA, class FB, class FS>
__global__ __launch_bounds__(256) void gemm_naive(int M, int N, int K, int pad_, FA fa, FB fb, FS fs) {
    __shared__ float As[16][65], Bs[16][65];
    const int z = blockIdx.z, m0 = blockIdx.y * 64, n0 = blockIdx.x * 64, tx = threadIdx.x & 15, ty = threadIdx.x >> 4;
    float acc[4][4];
#pragma unroll
    for (int i = 0; i < 4; ++i)
#pragma unroll
        for (int j = 0; j < 4; ++j) acc[i][j] = 0.f;
    for (int k0 = 0; k0 < K; k0 += 16) {
#pragma unroll
        for (int i = 0; i < 4; ++i) { const int idx = threadIdx.x + i * 256, kk = idx & 15, mm = idx >> 4; As[kk][mm] = (m0 + mm < M) ? fa(z, m0 + mm, k0 + kk) : 0.f; }
#pragma unroll
        for (int i = 0; i < 4; ++i) { const int idx = threadIdx.x + i * 256; int kk, nn; if (BT) { kk = idx & 15; nn = idx >> 4; } else { nn = idx & 63; kk = idx >> 6; }
            Bs[kk][nn] = (n0 + nn < N) ? fb(z, k0 + kk, n0 + nn) : 0.f; }
        __syncthreads();
#pragma unroll
        for (int kk = 0; kk < 16; ++kk) { float a[4], b[4];
#pragma unroll
            for (int i = 0; i < 4; ++i) { a[i] = As[kk][ty * 4 + i]; b[i] = Bs[kk][tx * 4 + i]; }
#pragma unroll
            for (int i = 0; i < 4; ++i)
#pragma unroll
                for (int j = 0; j < 4; ++j) acc[i][j] += a[i] * b[j]; }
        __syncthreads();
    }
#pragma unroll
    for (int i = 0; i < 4; ++i)
#pragma unroll
        for (int j = 0; j < 4; ++j) { const int m = m0 + ty * 4 + i, n = n0 + tx * 4 + j; if (m < M && n < N) fs(z, m, n, acc[i][j]); }
}
struct LdBf { const bf16_t* p; size_t zs; int ld; int pad;
    __device__ float operator()(int z, int r, int c) const { return bf2f(p[z * zs + (size_t)r * ld + c]); } };
struct LdBfT { const bf16_t* p; size_t zs; int ld; int pad;
    __device__ float operator()(int z, int k, int n) const { return bf2f(p[z * zs + (size_t)n * ld + k]); } };
struct LdF { const float* p; size_t zs; int ld; int pad;
    __device__ float operator()(int z, int r, int c) const { return p[z * zs + (size_t)r * ld + c]; } };

struct StInproj { bf16_t *G, *QLb, *KVLb, *RK;
    __device__ void operator()(int, int m, int n, float v) const {
        if (n < 2048) { if (m < NTOK) G[(size_t)m * 2048 + n] = f2bf(v); }
        else if (n < 2816) { if (m < NTOK) QLb[(size_t)m * 768 + (n - 2048)] = f2bf(v); }
        else if (n < 3328) KVLb[(size_t)m * 512 + (n - 2816)] = f2bf(v);
        else RK[(size_t)m * 64 + (n - 3328)] = f2bf(v); } };
__global__ void k_rstd(const bf16_t* __restrict__ QLb, const bf16_t* __restrict__ KVLb, float* __restrict__ rq, float* __restrict__ rkv, float* __restrict__ SSQP) {
    const int row = blockIdx.x * 256 + threadIdx.x; if (row >= NROW) return;
    for (int i = 0; i < 20; ++i) SSQP[(size_t)row * 20 + i] = 0.f;
    if (row < NTOK) { float s = 0.f; for (int i = 0; i < 768; ++i) { const float v = bf2f(QLb[(size_t)row * 768 + i]); s += v * v; } rq[row] = rsqrtf(s / 768.f + EPS); SSQP[(size_t)row * 20] = s; }
    { float s = 0.f; for (int i = 0; i < 512; ++i) { const float v = bf2f(KVLb[(size_t)row * 512 + i]); s += v * v; } rkv[row] = rsqrtf(s / 512.f + EPS); SSQP[(size_t)row * 20 + 12] = s; }
}
struct StQ { bf16_t* Q; const float* rq; __device__ void operator()(int, int m, int n, float v) const { Q[(size_t)m * 1536 + n] = f2bf(v * rq[m]); } };
struct StKV { bf16_t *KN, *V; const float* rkv;
    __device__ void operator()(int, int m, int n, float v) const { const int h = n >> 8, j = n & 255; v *= rkv[m];
        if (j < 128) KN[(size_t)m * 1024 + h * 128 + j] = f2bf(v);
        else { int b, key; if (m < NTOK) { b = m >> 12; key = m & 4095; } else { b = (m - NTOK) >> 8; key = SEQ + ((m - NTOK) & 255); }
            V[((size_t)(b * NH + h) * NKEY + key) * HV + (j - 128)] = f2bf(v); } } };

__global__ void k_qkprep(const bf16_t* __restrict__ QRAW, const bf16_t* __restrict__ KNRAW, const bf16_t* __restrict__ RK, const float* __restrict__ gq, const float* __restrict__ gk,
                         bf16_t* __restrict__ Qf, bf16_t* __restrict__ Kf) {
    const int id = blockIdx.x * 256 + threadIdx.x;
    const int nq = NTOK * NH, nk = NROW * NH;
    if (id >= nq + nk) return;
    const bool isq = id < nq; const int it = isq ? id : id - nq; const int row = it >> 3, h = it & 7;
    const bf16_t* a = isq ? QRAW + (size_t)row * 1536 + h * 192 : KNRAW + (size_t)row * 1024 + h * 128;
    const bf16_t* r = isq ? a + 128 : RK + (size_t)row * 64;
    const float* g = isq ? gq : gk;
    float s = 0.f;
    for (int d = 0; d < 128; ++d) { const float v = bf2f(a[d]); s += v * v; }
    for (int d = 0; d < 64; ++d) { const float v = bf2f(r[d]); s += v * v; }
    const float rstd = rsqrtf(s / 192.f + EPS);
    int b, pos; const bool lat = row < NTOK;
    if (lat) { b = row >> 12; pos = row & 4095; } else { b = (row - NTOK) >> 8; pos = SEQ + ((row - NTOK) & 255); }
    bf16_t* o = isq ? Qf + ((size_t)(b * NH + h) * SEQ + pos) * HQK : Kf + ((size_t)(b * NH + h) * NKEY + pos) * HQK;
    for (int d = 0; d < 128; ++d) o[d] = f2bf(bf2f(a[d]) * rstd * g[d]);
    const int prow = (pos & 4095) >> 6, pcol = pos & 63;
    for (int e = 0; e < 64; ++e) {
        const float xe = bf2f(r[e]) * rstd * g[128 + e]; float outv = xe;
        if (lat) { const int ax = e >> 5, i = e & 31, f = i & 15; const float p = (float)(ax ? pcol : prow);
            const float inv = powf(10000.f, -(float)f / 16.f); const float ang = p * inv; const float cs = cosf(ang), sn = sinf(ang);
            if (i < 16) { const float x2 = bf2f(r[e + 16]) * rstd * g[128 + e + 16]; outv = xe * cs - x2 * sn; }
            else { const float x1 = bf2f(r[e - 16]) * rstd * g[128 + e - 16]; outv = x1 * sn + xe * cs; } }
        o[128 + e] = f2bf(outv); }
}

struct StF { float* p; size_t zs; int ld; int pad; __device__ void operator()(int z, int m, int n, float v) const { p[z * zs + (size_t)m * ld + n] = v; } };
__global__ void k_softmax(float* __restrict__ S) {
    const size_t row = (size_t)blockIdx.x * 4 + (threadIdx.x >> 6); const int lane = threadIdx.x & 63;
    float* p = S + row * NKEY; const float sc = 0.07216878364870323f;
    float mx = -1e30f; for (int i = lane; i < NKEY; i += 64) mx = fmaxf(mx, p[i] * sc); mx = wave_max(mx);
    float sum = 0.f; for (int i = lane; i < NKEY; i += 64) { const float e = expf(p[i] * sc - mx); p[i] = e; sum += e; } sum = wave_sum(sum);
    const float inv = 1.f / sum; for (int i = lane; i < NKEY; i += 64) p[i] *= inv;
}
struct StAtt { bf16_t* A; int b; int pad; __device__ void operator()(int z, int m, int n, float v) const { A[(size_t)(b * SEQ + m) * 1024 + z * 128 + n] = f2bf(v); } };

__global__ void k_dft1(const bf16_t* __restrict__ G, bf16_t* __restrict__ T1) {
    __shared__ float ct[64], st[64];
    if (threadIdx.x < 64) { ct[threadIdx.x] = cospif((float)threadIdx.x / 32.f); st[threadIdx.x] = sinpif((float)threadIdx.x / 32.f); }
    __syncthreads();
    const int col = blockIdx.x * 256 + threadIdx.x, orow = blockIdx.y, b = blockIdx.z, k1 = orow >> 6, n2 = orow & 63;
    float tr = 0.f, ti = 0.f;
    for (int n1 = 0; n1 < 64; ++n1) { const size_t ir = (size_t)(b * SEQ + 64 * n1 + n2) * 2048; const float zr = bf2f(G[ir + col]), zi = bf2f(G[ir + 1024 + col]);
        const int m = (n1 * k1) & 63; const float c = ct[m], s = st[m]; tr += zr * c + zi * s; ti += zi * c - zr * s; }
    const float x = (float)(n2 * k1) / 2048.f, c = cospif(x), s = sinpif(x);
    const size_t orw = (size_t)(b * SEQ + orow) * 2048;
    T1[orw + col] = f2bf(tr * c + ti * s); T1[orw + 1024 + col] = f2bf(ti * c - tr * s);
}
__global__ void k_dft2(const bf16_t* __restrict__ T1, bf16_t* __restrict__ Y) {
    __shared__ float ct[64], st[64];
    if (threadIdx.x < 64) { ct[threadIdx.x] = cospif((float)threadIdx.x / 32.f); st[threadIdx.x] = sinpif((float)threadIdx.x / 32.f); }
    __syncthreads();
    const int col = blockIdx.x * 256 + threadIdx.x, orow = blockIdx.y, b = blockIdx.z, k1 = orow & 63, k2 = orow >> 6;
    float acc = 0.f;
    for (int n2 = 0; n2 < 64; ++n2) { const size_t ir = (size_t)(b * SEQ + 64 * k1 + n2) * 2048; const int m = (n2 * k2) & 63;
        acc += bf2f(T1[ir + col]) * ct[m] + bf2f(T1[ir + 1024 + col]) * st[m]; }
    Y[(size_t)(b * SEQ + orow) * 1024 + col] = f2bf(acc * (1.f / 1024.f));
}
__global__ void k_mixnorm(const bf16_t* __restrict__ Y, const bf16_t* __restrict__ ATT, bf16_t* __restrict__ MIXA) {
    const int row = blockIdx.x * 4 + (threadIdx.x >> 6), lane = threadIdx.x & 63;
    float sf = 0.f, sa = 0.f;
    for (int i = lane; i < 1024; i += 64) { const float a = bf2f(Y[(size_t)row * 1024 + i]), c = bf2f(ATT[(size_t)row * 1024 + i]); sf += a * a; sa += c * c; }
    sf = wave_sum(sf); sa = wave_sum(sa);
    const float rf = rsqrtf(sf / 1024.f + EPS), ra = rsqrtf(sa / 1024.f + EPS);
    for (int i = lane; i < 1024; i += 64) { MIXA[(size_t)row * 2048 + i] = f2bf(bf2f(Y[(size_t)row * 1024 + i]) * rf); MIXA[(size_t)row * 2048 + 1024 + i] = f2bf(bf2f(ATT[(size_t)row * 1024 + i]) * ra); }
}
struct StOut { float* out; const float* x; const float* mod; __device__ void operator()(int, int m, int n, float v) const { const int b = m >> 12; out[(size_t)m * D + n] = x[(size_t)m * D + n] + mod[b * NMOD + 2 * D + n] * v; } };

__global__ void k_route(const float* __restrict__ xn, const float* __restrict__ g2, const float* __restrict__ mod, const float* __restrict__ wrg, const float* __restrict__ brg,
                        const float* __restrict__ wre, const float* __restrict__ bre, bf16_t* __restrict__ HM, int* __restrict__ cnt, int* __restrict__ toke, int* __restrict__ tokp,
                        int* __restrict__ sltok, float* __restrict__ slw) {
    __shared__ float hm[D]; __shared__ float red[4]; __shared__ float lg[72];
    const int t = blockIdx.x, b = t >> 12, tid = threadIdx.x;
    const float* src = xn + (size_t)t * D; float ss = 0.f;
    for (int k = tid; k < D; k += 256) { const float v = src[k]; ss += v * v; }
    ss = wave_sum(ss); if ((tid & 63) == 0) red[tid >> 6] = ss; __syncthreads();
    const float rstd = rsqrtf((red[0] + red[1] + red[2] + red[3]) / (float)D + EPS);
    const float* sh = mod + b * NMOD + 3 * D; const float* sc = mod + b * NMOD + 4 * D;
    for (int k = tid; k < D; k += 256) { const float v = src[k] * rstd * g2[k] * (1.f + sc[k]) + sh[k]; hm[k] = v; HM[(size_t)t * D + k] = f2bf(v); }
    __syncthreads();
    if (tid < 72) { float acc = 0.f;
        if (tid < 8) { for (int k = 0; k < D; ++k) acc += hm[k] * wrg[k * 8 + tid]; acc += brg[tid]; }
        else { const int j = tid - 8; for (int k = 0; k < D; ++k) acc += hm[k] * wre[k * 64 + j]; acc += bre[j]; }
        lg[tid] = acc; }
    __syncthreads();
    if (tid == 0) {
        int gi = 0; float gm = lg[0]; for (int j = 1; j < 8; ++j) if (lg[j] > gm) { gm = lg[j]; gi = j; }
        float gs = 0.f; for (int j = 0; j < 8; ++j) gs += expf(lg[j] - gm); const float gp = 1.f / gs;
        const float* el = lg + 8 + gi * 8;
        int i0 = 0; float m0 = el[0]; for (int j = 1; j < 8; ++j) if (el[j] > m0) { m0 = el[j]; i0 = j; }
        int i1 = -1; float m1 = -1e30f; for (int j = 0; j < 8; ++j) if (j != i0 && el[j] > m1) { m1 = el[j]; i1 = j; }
        const float r = expf(m1 - m0), p0 = 1.f / (1.f + r), p1 = r / (1.f + r);
        const int e0 = gi * 8 + i0, e1 = gi * 8 + i1;
        const int q0 = atomicAdd(&cnt[e0], 1), q1 = atomicAdd(&cnt[e1], 1);
        toke[t * 2] = e0; toke[t * 2 + 1] = e1; tokp[t * 2] = q0; tokp[t * 2 + 1] = q1;
        sltok[e0 * ECAP + q0] = t; sltok[e1 * ECAP + q1] = t; slw[e0 * ECAP + q0] = gp * p0; slw[e1 * ECAP + q1] = gp * p1; }
}

__global__ __launch_bounds__(256) void k_moe_up(const bf16_t* __restrict__ HM, const float* __restrict__ wg, const float* __restrict__ wu, const int* __restrict__ cnt, const int* __restrict__ sltok, bf16_t* __restrict__ H) {
    __shared__ float As[16][65], Bg[16][65], Bu[16][65]; __shared__ int toks[64];
    const int e = blockIdx.z, c = cnt[e], m0 = blockIdx.y * 64; if (m0 >= c) return;
    int base = 0; for (int i = 0; i < e; ++i) base += cnt[i];
    const int n0 = blockIdx.x * 64, tx = threadIdx.x & 15, ty = threadIdx.x >> 4;
    if (threadIdx.x < 64) toks[threadIdx.x] = (m0 + (int)threadIdx.x < c) ? sltok[e * ECAP + m0 + threadIdx.x] : -1;
    __syncthreads();
    const float* G = wg + (size_t)e * D * DE; const float* U = wu + (size_t)e * D * DE;
    float ag[4][4], au[4][4];
#pragma unroll
    for (int i = 0; i < 4; ++i)
#pragma unroll
        for (int j = 0; j < 4; ++j) { ag[i][j] = 0.f; au[i][j] = 0.f; }
    for (int k0 = 0; k0 < D; k0 += 16) {
#pragma unroll
        for (int i = 0; i < 4; ++i) { const int idx = threadIdx.x + i * 256, kk = idx & 15, mm = idx >> 4; const int tk = toks[mm]; As[kk][mm] = tk >= 0 ? bf2f(HM[(size_t)tk * D + k0 + kk]) : 0.f; }
#pragma unroll
        for (int i = 0; i < 4; ++i) { const int idx = threadIdx.x + i * 256, nn = idx & 63, kk = idx >> 6; Bg[kk][nn] = G[(size_t)(k0 + kk) * DE + n0 + nn]; Bu[kk][nn] = U[(size_t)(k0 + kk) * DE + n0 + nn]; }
        __syncthreads();
#pragma unroll
        for (int kk = 0; kk < 16; ++kk) { float a[4], bg[4], bu[4];
#pragma unroll
            for (int i = 0; i < 4; ++i) { a[i] = As[kk][ty * 4 + i]; bg[i] = Bg[kk][tx * 4 + i]; bu[i] = Bu[kk][tx * 4 + i]; }
#pragma unroll
            for (int i = 0; i < 4; ++i)
#pragma unroll
                for (int j = 0; j < 4; ++j) { ag[i][j] += a[i] * bg[j]; au[i][j] += a[i] * bu[j]; } }
        __syncthreads();
    }
#pragma unroll
    for (int i = 0; i < 4; ++i)
#pragma unroll
        for (int j = 0; j < 4; ++j) { const int m = m0 + ty * 4 + i, n = n0 + tx * 4 + j; if (m < c) { const float g = ag[i][j]; H[(size_t)(base + m) * DE + n] = f2bf(g / (1.f + expf(-g)) * au[i][j]); } }
}
__global__ __launch_bounds__(256) void k_moe_down(const bf16_t* __restrict__ H, const float* __restrict__ wd, const int* __restrict__ cnt, const float* __restrict__ slw, bf16_t* __restrict__ YS) {
    __shared__ float As[16][65], Bs[16][65];
    const int e = blockIdx.z, c = cnt[e], m0 = blockIdx.y * 64; if (m0 >= c) return;
    int base = 0; for (int i = 0; i < e; ++i) base += cnt[i];
    const int n0 = blockIdx.x * 64, tx = threadIdx.x & 15, ty = threadIdx.x >> 4;
    const float* W = wd + (size_t)e * DE * D;
    float acc[4][4];
#pragma unroll
    for (int i = 0; i < 4; ++i)
#pragma unroll
        for (int j = 0; j < 4; ++j) acc[i][j] = 0.f;
    for (int k0 = 0; k0 < DE; k0 += 16) {
#pragma unroll
        for (int i = 0; i < 4; ++i) { const int idx = threadIdx.x + i * 256, kk = idx & 15, mm = idx >> 4; As[kk][mm] = (m0 + mm < c) ? bf2f(H[(size_t)(base + m0 + mm) * DE + k0 + kk]) : 0.f; }
#pragma unroll
        for (int i = 0; i < 4; ++i) { const int idx = threadIdx.x + i * 256, nn = idx & 63, kk = idx >> 6; Bs[kk][nn] = W[(size_t)(k0 + kk) * D + n0 + nn]; }
        __syncthreads();
#pragma unroll
        for (int kk = 0; kk < 16; ++kk) { float a[4], b[4];
#pragma unroll
            for (int i = 0; i < 4; ++i) { a[i] = As[kk][ty * 4 + i]; b[i] = Bs[kk][tx * 4 + i]; }
#pragma unroll
            for (int i = 0; i < 4; ++i)
#pragma unroll
                for (int j = 0; j < 4; ++j) acc[i][j] += a[i] * b[j]; }
        __syncthreads();
    }
#pragma unroll
    for (int i = 0; i < 4; ++i)
#pragma unroll
        for (int j = 0; j < 4; ++j) { const int m = m0 + ty * 4 + i, n = n0 + tx * 4 + j; if (m < c) YS[(size_t)(base + m) * D + n] = f2bf(acc[i][j] * slw[e * ECAP + m]); }
}
__global__ void k_combine(float* __restrict__ out, const float* __restrict__ mod, const bf16_t* __restrict__ YS, const int* __restrict__ cnt, const int* __restrict__ toke, const int* __restrict__ tokp) {
    __shared__ int base[NEXP];
    if (threadIdx.x == 0) { int s = 0; for (int i = 0; i < NEXP; ++i) { base[i] = s; s += cnt[i]; } }
    __syncthreads();
    const int t = blockIdx.x, b = t >> 12;
    const int s0 = base[toke[t * 2]] + tokp[t * 2], s1 = base[toke[t * 2 + 1]] + tokp[t * 2 + 1];
    const float* gt = mod + b * NMOD + 5 * D;
    for (int n = threadIdx.x; n < D; n += 256) out[(size_t)t * D + n] += gt[n] * (bf2f(YS[(size_t)s0 * D + n]) + bf2f(YS[(size_t)s1 * D + n]));
}

#if 0
__global__ __launch_bounds__(512, 2) void k_g_inproj(pg8::Gemm g, pg8::EpiInproj E) {
    extern __shared__ __attribute__((aligned(16))) unsigned char shm[];
    pg8::OrdInproj S; S.G = (int)gridDim.x; S.c = (int)blockIdx.x;
    pg8::gemm_phase<pg8::EpiInproj, pg8::OrdInproj, false>((PG8_LAS unsigned char*)shm, g, S, E, nullptr);
}
__global__ __launch_bounds__(512, 2) void k_g_qkv(pg8::Gemm gq, pg8::EpiQ Eq, pg8::Gemm gkv, pg8::EpiKV Ekv) {
    extern __shared__ __attribute__((aligned(16))) unsigned char shm[];
    { pg8::OrdGrid S; S.nM = 32; S.nN = 6; S.G = (int)gridDim.x; S.c = (int)blockIdx.x; if ((int)blockIdx.x < 192) pg8::gemm_phase<pg8::EpiQ, pg8::OrdGrid, false>((PG8_LAS unsigned char*)shm, gq, S, Eq, nullptr); }
    __syncthreads();
    { pg8::OrdKV S; S.c = (int)blockIdx.x; pg8::gemm_phase<pg8::EpiKV, pg8::OrdKV, false>((PG8_LAS unsigned char*)shm, gkv, S, Ekv, nullptr); }
}
__global__ __launch_bounds__(512, 2) void k_g_out(pg8::Gemm g, pg8::EpiOut E) {
    extern __shared__ __attribute__((aligned(16))) unsigned char shm[];
    pg8::OrdGrid S; S.nM = 32; S.nN = 8; S.G = (int)gridDim.x; S.c = (int)blockIdx.x;
    pg8::gemm_phase<pg8::EpiOut, pg8::OrdGrid, false>((PG8_LAS unsigned char*)shm, g, S, E, nullptr);
}

#endif
__device__ __forceinline__ void attn_phase(const bf16_t* Qf, const bf16_t* Kf, const bf16_t* Vf, bf16_t* ATT, char* lds, int c, int G, const float* wg, const float* wu, unsigned char* w8) {
    for (int u = c; u < 256; u += G) {
        const att::SideJob sj{wg, wu, w8, u * 68, G == 256 ? 17408 : 0};
        const int x = u & 7, j = u >> 3, pair = 2 * x + (j >> 4), qb = j & 15, b = pair >> 3, h = pair & 7;
        att::attn_body(Qf + ((size_t)pair * SEQ + qb * 256) * HQK, Kf + (size_t)pair * NKEY * HQK, Vf + (size_t)pair * NKEY * HV,
                       ATT + ((size_t)(b * SEQ + qb * 256)) * 1024 + h * 128, 1024, NKEY, lds, sj);
    }
}
#if 0
__global__ __launch_bounds__(512, 2) void k_attn(const bf16_t* Qf, const bf16_t* Kf, const bf16_t* Vf, bf16_t* ATT) {
    extern __shared__ __attribute__((aligned(16))) unsigned char shm[];
    attn_phase(Qf, Kf, Vf, ATT, (char*)shm, (int)blockIdx.x, (int)gridDim.x);
}

__global__ __launch_bounds__(512, 2) void k_moe_up_opt(const bf16_t* HM, const int* sltok, const float* wg, const float* wu, bf16_t* H, const int* cnt) {
    extern __shared__ __attribute__((aligned(16))) unsigned char shm[];
    moe::moe_phase<0>(HM, sltok, nullptr, wg, wu, H, cnt, (char*)shm, (int)blockIdx.x, (int)gridDim.x);
}
__global__ __launch_bounds__(512, 2) void k_moe_down_opt(const bf16_t* H, const float* slw, const float* wd, bf16_t* YS, const int* cnt) {
    extern __shared__ __attribute__((aligned(16))) unsigned char shm[];
    moe::moe_phase<1>(H, nullptr, slw, wd, nullptr, YS, cnt, (char*)shm, (int)blockIdx.x, (int)gridDim.x);
}
__global__ void k_rstd2(const float* __restrict__ SSQP, float* __restrict__ rq, float* __restrict__ rkv) {
    const int row = blockIdx.x * 256 + threadIdx.x; if (row >= NROW) return;
    const float* p = SSQP + (size_t)row * 20; float a = 0.f, b = 0.f;
    for (int i = 0; i < 12; ++i) a += p[i]; for (int i = 12; i < 20; ++i) b += p[i];
    rq[row] = rsqrtf(a / 768.f + EPS); rkv[row] = rsqrtf(b / 512.f + EPS);
}

#endif
#define XB_TMO      128
#define XB_XCNT(j)  (256  + 64 * (j))
#define XB_XSUB(j)  (1280 + 64 * (j))
#define XB_XGEN(j)  (2304 + 64 * (j))
#define XB_TOP      3328
#define XB_TOPGEN   3392
#define XCD_BAR_WORDS 3456
#define XB_SPIN_CAP (1u << 18)
#define LAS __attribute__((address_space(3)))
__device__ __forceinline__ unsigned xb_ld(unsigned* p)              { return __hip_atomic_load(p, __ATOMIC_RELAXED, __HIP_MEMORY_SCOPE_AGENT); }
__device__ __forceinline__ unsigned xb_add(unsigned* p, unsigned v) { return __hip_atomic_fetch_add(p, v, __ATOMIC_RELAXED, __HIP_MEMORY_SCOPE_AGENT); }
__device__ __forceinline__ unsigned xb_xcc_id() { return (unsigned)__builtin_amdgcn_s_getreg((3 << 11) | 20) & 0xFu; }
#define XB_SPIN(cond, bar) do { unsigned _sp = 0; while (cond) { __builtin_amdgcn_s_sleep(1); \
    if ((++_sp & 255u) == 0u) { if (xb_ld(&(bar)[XB_TMO])) break; if (_sp > XB_SPIN_CAP) { atomicAdd(&(bar)[XB_TMO], 1u); break; } } } } while (0)
struct XcdBarrier { unsigned* bar; unsigned x; volatile LAS unsigned* st; };
__device__ __forceinline__ XcdBarrier xcd_barrier_post(unsigned* bar, volatile LAS unsigned* st) {
    XcdBarrier b; b.bar = bar; b.x = xb_xcc_id(); b.st = st;
    if (threadIdx.x == 0) (void)xb_add(&bar[XB_XCNT(b.x)], 1u);
    return b;
}
__device__ __forceinline__ void xcd_barrier_complete(unsigned* bar, unsigned x, unsigned& nloc, unsigned& nx) {
    const unsigned G = gridDim.x * gridDim.y * gridDim.z;
    unsigned sum, cnt, mine, sp = 0u;
    for (;;) {
        sum = 0u; cnt = 0u; mine = 0u;
#pragma unroll
        for (unsigned j = 0; j < 16; ++j) { const unsigned c = xb_ld(&bar[XB_XCNT(j)]); sum += c; cnt += (c > 0u) ? 1u : 0u; mine = (j == x) ? c : mine; }
        if (sum == G) break;
        __builtin_amdgcn_s_sleep(1);
        if ((++sp & 255u) == 0u) { if (xb_ld(&bar[XB_TMO])) break; if (sp > XB_SPIN_CAP) { atomicAdd(&bar[XB_TMO], 1u); break; } }
    }
    nloc = mine > 0u ? mine : 1u; nx = cnt > 0u ? cnt : 1u;
}
__device__ __forceinline__ void xcd_barrier(const XcdBarrier& b) {
    asm volatile("s_waitcnt vmcnt(0)" ::: "memory");
    __syncthreads();
    if (threadIdx.x == 0) {
        unsigned* bar = b.bar;
        __builtin_amdgcn_s_waitcnt(0);
        unsigned nloc = b.st[0], nx = b.st[1];
        if (nloc == 0u) { xcd_barrier_complete(bar, b.x, nloc, nx); b.st[0] = nloc; b.st[1] = nx; }
        const unsigned old = xb_add(&bar[XB_XSUB(b.x)], 1u);
        const unsigned gen = old / nloc;
        if (old + 1u == (gen + 1u) * nloc) {
            __builtin_amdgcn_fence(__ATOMIC_RELEASE, "agent");
            asm volatile("s_waitcnt vmcnt(0)" ::: "memory");
            const unsigned og = xb_add(&bar[XB_TOP], 1u);
            const unsigned tg = og / nx;
            if (og + 1u == (tg + 1u) * nx) xb_add(&bar[XB_TOPGEN], 1u);
            else XB_SPIN(xb_ld(&bar[XB_TOPGEN]) == tg, bar);
            __builtin_amdgcn_fence(__ATOMIC_ACQUIRE, "agent");
            xb_add(&bar[XB_XGEN(b.x)], 1u);
            asm volatile("s_waitcnt vmcnt(0)" ::: "memory");
        } else {
            XB_SPIN(xb_ld(&bar[XB_XGEN(b.x)]) == gen, bar);
            __builtin_amdgcn_fence(__ATOMIC_ACQUIRE, "agent");
            asm volatile("s_waitcnt vmcnt(0)" ::: "memory");
        }
    }
    __syncthreads();
}

namespace dft {
using u32x4 = __attribute__((ext_vector_type(4))) unsigned;
using bf16x8 = __attribute__((ext_vector_type(8))) short;
using s16x4  = __attribute__((ext_vector_type(4))) short;
using f32x16 = __attribute__((ext_vector_type(16))) float;
constexpr int ROWB = 320, LDS_BYTES = 128 * ROWB;
__device__ __forceinline__ int crow(int r, int hi) { return (r & 3) + 8 * (r >> 2) + 4 * hi; }
__device__ __forceinline__ unsigned cvtpk(float lo, float hi) { unsigned r; asm volatile("v_cvt_pk_bf16_f32 %0, %1, %2" : "=v"(r) : "v"(lo), "v"(hi)); return r; }
template <int OFF> __device__ __forceinline__ s16x4 tr_read(int vb) { s16x4 r; asm volatile("ds_read_b64_tr_b16 %0, %1 offset:%2" : "=&v"(r) : "v"(vb), "i"(OFF) : "memory"); return r; }
template <int KS> __device__ __forceinline__ bf16x8 bfrag(int vb) {
    const s16x4 l = tr_read<KS * 16 * ROWB>(vb), h = tr_read<KS * 16 * ROWB + 4 * ROWB>(vb);
    asm volatile("s_waitcnt lgkmcnt(0)" ::: "memory"); __builtin_amdgcn_sched_barrier(0);
    return (bf16x8){l[0], l[1], l[2], l[3], h[0], h[1], h[2], h[3]};
}
template <int STAGE>
__device__ __forceinline__ void phase(const bf16_t* __restrict__ in, bf16_t* __restrict__ out, char* lds, int c, int G) {
    const int tid = threadIdx.x, wid = __builtin_amdgcn_readfirstlane(tid >> 6), lane = tid & 63, r32 = lane & 31, hi = lane >> 5, kt = wid & 1, ct = wid >> 1;
    bf16x8 Are[8], Aim[8];
#pragma unroll
    for (int ks = 0; ks < 8; ++ks) { unsigned wr_[4], wi_[4];
#pragma unroll
        for (int j2 = 0; j2 < 4; ++j2) { float cr[2], ci[2];
#pragma unroll
            for (int e = 0; e < 2; ++e) { const int idx = 16 * ks + 8 * hi + 2 * j2 + e, n = idx & 63, m = ((32 * kt + r32) * n) & 63;
                const float cs = cospif((float)m / 32.f), sn = sinpif((float)m / 32.f);
                cr[e] = idx < 64 ? cs : sn; ci[e] = idx < 64 ? -sn : cs; }
            wr_[j2] = cvtpk(cr[0], cr[1]); wi_[j2] = cvtpk(ci[0], ci[1]); }
        Are[ks] = *reinterpret_cast<bf16x8*>(wr_); Aim[ks] = *reinterpret_cast<bf16x8*>(wi_); }
    const int q = (lane & 15) >> 2, p = lane & 3, g16 = (lane >> 4) & 1;
    const int vb = (int)(uintptr_t)lds + (8 * hi + q) * ROWB + (32 * ct + 16 * g16 + 4 * p) * 2;
    u32x4 pre[4];
#define DFT_LOAD(tt) do { const int b_ = (tt) >> 9, r_ = ((tt) >> 3) & 63, cc_ = (tt) & 7; _Pragma("unroll") for (int i = 0; i < 4; ++i) { const int id = tid + 512 * i, lrow = id >> 4, ch = id & 15, part = lrow >> 6, m = lrow & 63; \
        const int grow = b_ * 4096 + (STAGE == 1 ? 64 * m + r_ : 64 * r_ + m); pre[i] = *(const u32x4*)(in + (size_t)grow * 2048 + part * 1024 + cc_ * 128 + ch * 8); } } while (0)
    if (c < 1024) DFT_LOAD(c);
    for (int t = c; t < 1024; t += G) {
        const int b = t >> 9, r = (t >> 3) & 63, cc = t & 7;
        __syncthreads();
#pragma unroll
        for (int i = 0; i < 4; ++i) { const int id = tid + 512 * i; *(u32x4*)(lds + (id >> 4) * ROWB + (id & 15) * 16) = pre[i]; }
        __syncthreads();
        { const int tn = t + G < 1024 ? t + G : t; DFT_LOAD(tn); }
        f32x16 are = {}, aim = {};
#define DFT_STEP(KS) do { const bf16x8 bb = bfrag<KS>(vb); are = __builtin_amdgcn_mfma_f32_32x32x16_bf16(Are[KS], bb, are, 0, 0, 0); \
        if (STAGE == 1) aim = __builtin_amdgcn_mfma_f32_32x32x16_bf16(Aim[KS], bb, aim, 0, 0, 0); } while (0)
        DFT_STEP(0); DFT_STEP(1); DFT_STEP(2); DFT_STEP(3); DFT_STEP(4); DFT_STEP(5); DFT_STEP(6); DFT_STEP(7);
#undef DFT_STEP
        __syncthreads();
        bf16_t* ol = (bf16_t*)lds;
#pragma unroll
        for (int rr = 0; rr < 16; ++rr) { const int ko = 32 * kt + crow(rr, hi), lc = 32 * ct + r32;
            if (STAGE == 1) { const float ph = (float)(r * ko) / 2048.f, cs = cospif(ph), sn = sinpif(ph), tr = are[rr], ti = aim[rr];
                ol[ko * (ROWB / 2) + lc] = (bf16_t)(cvtpk(tr * cs + ti * sn, 0.f) & 0xffffu); ol[(64 + ko) * (ROWB / 2) + lc] = (bf16_t)(cvtpk(ti * cs - tr * sn, 0.f) & 0xffffu); }
            else ol[ko * (ROWB / 2) + lc] = (bf16_t)(cvtpk(are[rr] * (1.f / 1024.f), 0.f) & 0xffffu); }
        __syncthreads();
        if (STAGE == 1) {
#pragma unroll
            for (int i = 0; i < 4; ++i) { const int id = tid + 512 * i, lrow = id >> 4, ch = id & 15, part = lrow >> 6, ko = lrow & 63;
                *(u32x4*)(out + (size_t)(b * 4096 + 64 * ko + r) * 2048 + part * 1024 + cc * 128 + ch * 8) = *(const u32x4*)(lds + lrow * ROWB + ch * 16); }
        } else {
#pragma unroll
            for (int i = 0; i < 2; ++i) { const int id = tid + 512 * i, k2 = id >> 4, ch = id & 15;
                *(u32x4*)(out + (size_t)(b * 4096 + r + 64 * k2) * 1024 + cc * 128 + ch * 8) = *(const u32x4*)(lds + k2 * ROWB + ch * 16); }
        }
    }
#undef DFT_LOAD
}
}

namespace mk {
using f32x4 = __attribute__((ext_vector_type(4))) float;
using f32x16 = __attribute__((ext_vector_type(16))) float;
using u32x4 = __attribute__((ext_vector_type(4))) unsigned;
struct Params {
    const float *x, *c, *ctx, *cctx, *w_ada, *b_ada, *g1, *g2, *w_in, *g_q_a, *g_kv_a, *w_uq, *w_ukv, *g_qk_q, *g_qk_k, *g_of, *g_oa, *w_out, *w_rg, *b_rg, *w_re, *b_re, *w_gate, *w_up, *w_down;
    float* out; char* ws;
};
constexpr int LDS_XB = 0, LDS_PH = 64;
constexpr int LDS_PHASE_MAX = 132864;
constexpr int LDS_TOTAL = LDS_PH + LDS_PHASE_MAX;
__device__ __forceinline__ unsigned cvtpk(float lo, float hi) { unsigned r; asm volatile("v_cvt_pk_bf16_f32 %0, %1, %2" : "=v"(r) : "v"(lo), "v"(hi)); return r; }
__device__ __forceinline__ float bflo(unsigned w) { return __uint_as_float(w << 16); }
__device__ __forceinline__ float bfhi(unsigned w) { return __uint_as_float(w & 0xffff0000u); }

__device__ __forceinline__ void ada_unit(const Params& P, float* mod, int u, char* lds) {
    float* sc = (float*)lds; float* red = sc + 3 * 2048;
    const int tid = threadIdx.x;
    __syncthreads();
    for (int i = tid; i < 3 * 2048; i += 512) { const int r = i >> 11, k = i & 2047; const float v = r < 2 ? P.c[r * 2048 + k] : P.cctx[k]; sc[i] = v / (1.f + __expf(-v)); }
    __syncthreads();
    const int tq = tid & 15, ks = tid >> 4;
    const float* wp = P.w_ada + (size_t)(ks * 64) * 12288 + u * 64 + tq * 4;
    f32x4 a0 = {0.f, 0.f, 0.f, 0.f}, a1 = a0, a2 = a0;
#pragma unroll 16
    for (int kk = 0; kk < 64; ++kk) { const f32x4 wv = *(const f32x4*)(wp + (size_t)kk * 12288); const int k = ks * 64 + kk; a0 += wv * sc[k]; a1 += wv * sc[2048 + k]; a2 += wv * sc[4096 + k]; }
    float* rp = red + (ks * 16 + tq) * 12;
    *(f32x4*)(rp) = a0; *(f32x4*)(rp + 4) = a1; *(f32x4*)(rp + 8) = a2;
    __syncthreads();
    if (tid < 192) { const int r = tid >> 6, col = tid & 63, q4 = col >> 2, j = col & 3; float s = 0.f;
        for (int k2 = 0; k2 < 32; ++k2) s += red[(k2 * 16 + q4) * 12 + r * 4 + j];
        mod[r * 12288 + u * 64 + col] = s + P.b_ada[u * 64 + col]; }
}
struct TcvtDesc { const float* in; const float* s0; const float* s1; bf16_t* out; int ldin, coff, ssplit, ldo, k0, n0; };
__device__ __forceinline__ TcvtDesc tcvt_desc(const Params& P, char* ws, int j) {
    TcvtDesc d;
    if (j < 672) { d.in = P.w_in; d.ldin = INP; d.coff = 1024; d.s0 = nullptr; d.s1 = nullptr; d.ssplit = 0; d.out = (bf16_t*)(ws + WS_WINT) + (size_t)2048 * D; d.ldo = D; d.k0 = (j / 21) * 64; d.n0 = (j % 21) * 64; }
    else if (j < 960) { const int q = j - 672; d.in = P.w_uq; d.ldin = 1536; d.coff = 0; d.s0 = P.g_q_a; d.s1 = P.g_q_a; d.ssplit = 768; d.out = (bf16_t*)(ws + WS_WUQT); d.ldo = 768; d.k0 = (q / 24) * 64; d.n0 = (q % 24) * 64; }
    else if (j < 1216) { const int q = j - 960; d.in = P.w_ukv; d.ldin = 2048; d.coff = 0; d.s0 = P.g_kv_a; d.s1 = P.g_kv_a; d.ssplit = 512; d.out = (bf16_t*)(ws + WS_WUKVT); d.ldo = 512; d.k0 = (q / 32) * 64; d.n0 = (q % 32) * 64; }
    else { const int q = j - 1216; d.in = P.w_out; d.ldin = 2048; d.coff = 0; d.s0 = P.g_of; d.s1 = P.g_oa; d.ssplit = 1024; d.out = (bf16_t*)(ws + WS_WOUTT); d.ldo = 2048; d.k0 = (q / 32) * 64; d.n0 = (q % 32) * 64; }
    return d;
}
__device__ __forceinline__ void tcvt_load(const TcvtDesc& d, f32x4 (&v)[2]) {
    const int tid = threadIdx.x, r = tid >> 4, c4 = (tid & 15) * 4;
#pragma unroll
    for (int i = 0; i < 2; ++i) v[i] = *(const f32x4*)(d.in + (size_t)(d.k0 + r + 32 * i) * d.ldin + d.coff + d.n0 + c4);
}
__device__ __forceinline__ void tcvt_finish(const TcvtDesc& d, const f32x4 (&v)[2], char* lds) {
    float* t = (float*)lds;
    const int tid = threadIdx.x, r = tid >> 4, c4 = (tid & 15) * 4;
    __syncthreads();
#pragma unroll
    for (int i = 0; i < 2; ++i) { const int k = d.k0 + r + 32 * i; f32x4 x = v[i];
        if (d.s0) x *= (k < d.ssplit ? d.s0[k] : d.s1[k - d.ssplit]);
        float* tp = t + (r + 32 * i) * 65 + c4; tp[0] = x[0]; tp[1] = x[1]; tp[2] = x[2]; tp[3] = x[3]; }
    __syncthreads();
    const int n = tid >> 3, k8 = (tid & 7) * 8; float e[8];
#pragma unroll
    for (int j = 0; j < 8; ++j) e[j] = t[(k8 + j) * 65 + n];
    u32x4 w; w.x = cvtpk(e[0], e[1]); w.y = cvtpk(e[2], e[3]); w.z = cvtpk(e[4], e[5]); w.w = cvtpk(e[6], e[7]);
    *(u32x4*)(d.out + (size_t)(d.n0 + n) * d.ldo + d.k0 + k8) = w;
}
__device__ __forceinline__ void tcvt_tiles(const Params& P, char* ws, char* lds, int first, int stride, int hi) {
    if (first >= hi) return;
    TcvtDesc cur = tcvt_desc(P, ws, first); f32x4 v[2]; tcvt_load(cur, v);
    for (int j = first; j < hi; j += stride) { const int jn = j + stride < hi ? j + stride : j; const TcvtDesc nxt = tcvt_desc(P, ws, jn); f32x4 vn[2]; tcvt_load(nxt, vn);
        __builtin_amdgcn_sched_barrier(0);
        tcvt_finish(cur, v, lds); cur = nxt; v[0] = vn[0]; v[1] = vn[1]; }
    __syncthreads();
}
__device__ __forceinline__ void tcvt_range(const Params& P, char* ws, char* lds, int c, int G, int hi) { tcvt_tiles(P, ws, lds, c, G, hi); }
__device__ __forceinline__ void p0_jobs(const Params& P, char* lds, int c, int G) {
    char* ws = P.ws; const int tid = threadIdx.x;
    bf16_t* WinT = (bf16_t*)(ws + WS_WINT);
    bf16_t* WF = (bf16_t*)(ws + WS_WF); bf16_t* MT = (bf16_t*)(ws + WS_MT); float* WR = (float*)(ws + WS_WR);
    tcvt_range(P, ws, lds, c, G, 1216);
    const int gt = c * 512 + tid, gs = G * 512;
    for (int i = gt; i < 2048 * 128; i += gs) { const int k = i >> 7, c8 = (i & 127) * 8; const float* sp = P.w_in + (size_t)k * INP + c8;
        const f32x4 a = *(const f32x4*)sp, b = *(const f32x4*)(sp + 4); u32x4 w; w.x = cvtpk(a[0], a[1]); w.y = cvtpk(a[2], a[3]); w.z = cvtpk(b[0], b[1]); w.w = cvtpk(b[2], b[3]);
        *(u32x4*)(WF + (size_t)k * 1024 + c8) = w; }
    for (int i = gt; i < 512 * 32; i += gs) { const int jr = i >> 5, c8 = (i & 31) * 8, im = jr >> 8, kc = jr & 255; float e[8];
#pragma unroll
        for (int j = 0; j < 8; ++j) { const int m = ((c8 + j) * kc) & 255; const float xx = (float)m / 128.f; e[j] = im ? -sinpif(xx) : cospif(xx); }
        u32x4 w; w.x = cvtpk(e[0], e[1]); w.y = cvtpk(e[2], e[3]); w.z = cvtpk(e[4], e[5]); w.w = cvtpk(e[6], e[7]);
        *(u32x4*)(MT + (size_t)jr * 256 + c8) = w; }
    for (int i = gt; i < 2048 * 96; i += gs) { const int k = i / 96, j = i % 96; WR[i] = j < 8 ? P.w_rg[k * 8 + j] : (j < 72 ? P.w_re[k * 64 + (j - 8)] : 0.f); }
    { bf16_t* WRH = (bf16_t*)(ws + WS_WRH); bf16_t* WRL = (bf16_t*)(ws + WS_WRL);
      for (int i = gt; i < 80 * 256; i += gs) { const int o = i >> 8, k8 = (i & 255) * 8; float e[8]; unsigned hb[4], lb[4];
#pragma unroll
        for (int j = 0; j < 8; ++j) e[j] = o < 8 ? P.w_rg[(k8 + j) * 8 + o] : (o < 72 ? P.w_re[(k8 + j) * 64 + (o - 8)] : 0.f);
#pragma unroll
        for (int j = 0; j < 4; ++j) { hb[j] = cvtpk(e[2 * j], e[2 * j + 1]); lb[j] = cvtpk(e[2 * j] - bflo(hb[j]), e[2 * j + 1] - bfhi(hb[j])); }
        *(u32x4*)(WRH + (size_t)o * 2048 + k8) = (u32x4){hb[0], hb[1], hb[2], hb[3]}; *(u32x4*)(WRL + (size_t)o * 2048 + k8) = (u32x4){lb[0], lb[1], lb[2], lb[3]}; } }
    for (int i = gt; i < 192 * 2048 / 8; i += gs) *(u32x4*)(WinT + (size_t)3392 * D + (size_t)i * 8) = (u32x4){0u, 0u, 0u, 0u};
    if (c == 0 && tid < 64) ((int*)(ws + WS_CTL))[4096 + tid * 64] = 0;
}
__device__ __forceinline__ void hx_rows(const Params& P, const float* mod, bf16_t* HX, int c, int G) {
    int tid = threadIdx.x; asm volatile("" : "+v"(tid)); const int lane = tid & 63, stride = G * 8;
    for (int row0 = c * 8 + (tid >> 6); row0 < NROW; row0 += 2 * stride) {
        const int row1 = row0 + stride; const bool has1 = row1 < NROW; const int rr1 = has1 ? row1 : row0;
        const float* src0 = row0 < NTOK ? P.x + (size_t)row0 * D : P.ctx + (size_t)(row0 - NTOK) * D;
        const float* src1 = rr1 < NTOK ? P.x + (size_t)rr1 * D : P.ctx + (size_t)(rr1 - NTOK) * D;
        f32x4 v0[8], v1[8]; float ss0 = 0.f, ss1 = 0.f;
#pragma unroll
        for (int i = 0; i < 8; ++i) { v0[i] = *(const f32x4*)(src0 + i * 256 + lane * 4); v1[i] = *(const f32x4*)(src1 + i * 256 + lane * 4); }
#pragma unroll
        for (int i = 0; i < 8; ++i) { ss0 += (v0[i][0] * v0[i][0] + v0[i][1] * v0[i][1]) + (v0[i][2] * v0[i][2] + v0[i][3] * v0[i][3]); ss1 += (v1[i][0] * v1[i][0] + v1[i][1] * v1[i][1]) + (v1[i][2] * v1[i][2] + v1[i][3] * v1[i][3]); }
        const float rs0 = rsqrtf(wave_sum(ss0) * (1.f / 2048.f) + EPS), rs1 = rsqrtf(wave_sum(ss1) * (1.f / 2048.f) + EPS);
        const float* sh0 = mod + (row0 < NTOK ? row0 >> 12 : 2) * NMOD; const float* sh1 = mod + (rr1 < NTOK ? rr1 >> 12 : 2) * NMOD;
#pragma unroll
        for (int rr = 0; rr < 2; ++rr) { if (rr == 1 && !has1) break;
            const float* shp = rr ? sh1 : sh0; const float rs = rr ? rs1 : rs0; bf16_t* dst = HX + (size_t)(rr ? row1 : row0) * D; f32x4 gv[8], s1v[8], s0v[8];
#pragma unroll
            for (int i = 0; i < 8; ++i) { const int col = i * 256 + lane * 4; gv[i] = *(const f32x4*)(P.g1 + col); s1v[i] = *(const f32x4*)(shp + D + col); s0v[i] = *(const f32x4*)(shp + col); }
            __builtin_amdgcn_sched_barrier(0);
#pragma unroll
            for (int i = 0; i < 8; ++i) { const int col = i * 256 + lane * 4; const f32x4 o = (rr ? v1[i] : v0[i]) * rs * gv[i] * (s1v[i] + 1.f) + s0v[i]; uint2 w; w.x = cvtpk(o[0], o[1]); w.y = cvtpk(o[2], o[3]); *(uint2*)(dst + col) = w; }
            __builtin_amdgcn_sched_barrier(0); }
    }
}
__device__ __forceinline__ void qkprep(const Params& P, const bf16_t* QRAW, const bf16_t* KNRAW, const bf16_t* RK, bf16_t* Qf, bf16_t* Kf, char* lds, int c, int G) {
    float* tc = (float*)lds; float* ts = tc + 1024; float* gq = ts + 1024; float* gk = gq + 192;
    const int tid = threadIdx.x, lane = tid & 63, sub = lane & 7;
    __syncthreads();
    for (int i = tid; i < 1024; i += 512) { const int pos = i >> 4, f = i & 15; const float ang = (float)pos * powf(10000.f, -(float)f / 16.f); tc[i] = cosf(ang); ts[i] = sinf(ang); }
    if (tid < 192) { gq[tid] = P.g_qk_q[tid]; gk[tid] = P.g_qk_k[tid]; }
    __syncthreads();
    const int nq = NTOK * NH, ntask = nq + NROW * NH, stride = G * 64;
    for (int tb = c * 64 + (tid >> 3); tb < ntask; tb += 2 * stride) {
        u32x4 v0[2], v1[2], v2[2]; const bf16_t* aP[2]; const bf16_t* rP[2]; int tk[2];
#pragma unroll
        for (int s2 = 0; s2 < 2; ++s2) { int task = tb + s2 * stride; task = task < ntask ? task : tb; tk[s2] = task;
            const bool isq = task < nq; const int it = isq ? task : task - nq, row = it >> 3, h = it & 7;
            aP[s2] = isq ? QRAW + (size_t)row * 1536 + h * 192 : KNRAW + (size_t)row * 1024 + h * 128; rP[s2] = isq ? aP[s2] + 128 : RK + (size_t)row * 64;
            v0[s2] = *(const u32x4*)(aP[s2] + sub * 8); v1[s2] = *(const u32x4*)(aP[s2] + 64 + sub * 8); v2[s2] = *(const u32x4*)(rP[s2] + sub * 8); }
#pragma unroll
        for (int s2 = 0; s2 < 2; ++s2) { if (s2 == 1 && tb + stride >= ntask) break;
            const int task = tk[s2]; const bool isq = task < nq; const int it = isq ? task : task - nq, row = it >> 3, h = it & 7; const float* g = isq ? gq : gk;
            float ss = 0.f;
#pragma unroll
            for (int j = 0; j < 4; ++j) { const float a = bflo(v0[s2][j]), b = bfhi(v0[s2][j]), c2 = bflo(v1[s2][j]), d = bfhi(v1[s2][j]), e = bflo(v2[s2][j]), f = bfhi(v2[s2][j]); ss += (a * a + b * b) + (c2 * c2 + d * d) + (e * e + f * f); }
            ss += __shfl_xor(ss, 1); ss += __shfl_xor(ss, 2); ss += __shfl_xor(ss, 4);
            const float rstd = rsqrtf(ss * (1.f / 192.f) + EPS);
            const bool lat = row < NTOK; int b, pos;
            if (lat) { b = row >> 12; pos = row & 4095; } else { b = (row - NTOK) >> 8; pos = SEQ + ((row - NTOK) & 255); }
            bf16_t* o = isq ? Qf + ((size_t)(b * NH + h) * SEQ + pos) * HQK : Kf + ((size_t)(b * NH + h) * NKEY + pos) * HQK;
            u32x4 w0, w1, w2;
#pragma unroll
            for (int j = 0; j < 4; ++j) { w0[j] = cvtpk(bflo(v0[s2][j]) * rstd * g[sub * 8 + 2 * j], bfhi(v0[s2][j]) * rstd * g[sub * 8 + 2 * j + 1]);
                w1[j] = cvtpk(bflo(v1[s2][j]) * rstd * g[64 + sub * 8 + 2 * j], bfhi(v1[s2][j]) * rstd * g[64 + sub * 8 + 2 * j + 1]); }
            const int ax = sub >> 2, pp = ax ? (pos & 63) : ((pos & 4095) >> 6); const bool second = (sub & 2) != 0;
#pragma unroll
            for (int j = 0; j < 4; ++j) { const unsigned pw = __shfl_xor(v2[s2][j], 2);
                const int e = sub * 8 + 2 * j, ep = (sub ^ 2) * 8 + 2 * j, f = (sub & 1) * 8 + 2 * j;
                const float xoa = bflo(v2[s2][j]) * rstd * g[128 + e], xob = bfhi(v2[s2][j]) * rstd * g[128 + e + 1], xpa = bflo(pw) * rstd * g[128 + ep], xpb = bfhi(pw) * rstd * g[128 + ep + 1];
                float oa = xoa, ob = xob;
                if (lat) { const float ca = tc[pp * 16 + f], sa = ts[pp * 16 + f], cb = tc[pp * 16 + f + 1], sb = ts[pp * 16 + f + 1];
                    oa = second ? xpa * sa + xoa * ca : xoa * ca - xpa * sa; ob = second ? xpb * sb + xob * cb : xob * cb - xpb * sb; }
                w2[j] = cvtpk(oa, ob); }
            *(u32x4*)(o + sub * 8) = w0; *(u32x4*)(o + 64 + sub * 8) = w1; *(u32x4*)(o + 128 + sub * 8) = w2; }
    }
}
__device__ __forceinline__ void mixnorm(const bf16_t* Y, const bf16_t* ATT, bf16_t* MIXA, int c, int G) {
    int tid = threadIdx.x; asm volatile("" : "+v"(tid)); const int lane = tid & 63;
    for (int row = c * 8 + (tid >> 6); row < NTOK; row += G * 8) {
#pragma unroll
        for (int part = 0; part < 2; ++part) { const bf16_t* src = (part ? ATT : Y) + (size_t)row * 1024;
            const u32x4 a = *(const u32x4*)(src + lane * 8), b = *(const u32x4*)(src + 512 + lane * 8); float ss = 0.f;
#pragma unroll
            for (int j = 0; j < 4; ++j) { const float a0 = bflo(a[j]), a1 = bfhi(a[j]), b0 = bflo(b[j]), b1 = bfhi(b[j]); ss += (a0 * a0 + a1 * a1) + (b0 * b0 + b1 * b1); }
            const float rs = rsqrtf(wave_sum(ss) * (1.f / 1024.f) + EPS); u32x4 oa, ob;
#pragma unroll
            for (int j = 0; j < 4; ++j) { oa[j] = cvtpk(bflo(a[j]) * rs, bfhi(a[j]) * rs); ob[j] = cvtpk(bflo(b[j]) * rs, bfhi(b[j]) * rs); }
            bf16_t* dst = MIXA + (size_t)row * 2048 + part * 1024; *(u32x4*)(dst + lane * 8) = oa; *(u32x4*)(dst + 512 + lane * 8) = ob; }
    }
}
__device__ __forceinline__ void route_consts(const Params& P, const float* mod, const float* WR, float* AB, float* SHW, int c, int G) {
    const int tid = threadIdx.x, lane = tid & 63;
    for (int i = c * 512 + tid; i < 2 * 2048; i += G * 512) { const int b = i >> 11, k = i & 2047; AB[i] = P.g2[k] * (1.f + mod[b * NMOD + 4 * D + k]); }
    for (int task = c * 8 + (tid >> 6); task < 2 * 96; task += G * 8) { const int b = task / 96, o = task % 96; const float* sh = mod + b * NMOD + 3 * D; float s = 0.f;
        for (int k = lane; k < 2048; k += 64) s += sh[k] * WR[(size_t)k * 96 + o];
        s = wave_sum(s); if (lane == 0) SHW[task] = s; }
}
constexpr int RT_PART = 0, RT_SSQ = 8 * 32 * 81 * 4, RT_RS = RT_SSQ + 8 * 32 * 4, RT_LG = RT_RS + 128, RT_BYTES = RT_LG + 32 * 81 * 4;
__device__ __forceinline__ void route(const Params& P, const float* mod, const float* AB, const float* SHW, const bf16_t* WRH, const bf16_t* WRL, bf16_t* HM, int* cnt, int* toke, int* tokp, int* sltok, float* slw, char* lds, int c, int G) {
    using bf16x8 = __attribute__((ext_vector_type(8))) short;
    const int tid = threadIdx.x, wid = __builtin_amdgcn_readfirstlane(tid >> 6), lane = tid & 63, l16 = lane & 15, fq = lane >> 4;
    float* part = (float*)(lds + RT_PART); float* ssqp = (float*)(lds + RT_SSQ); float* rs = (float*)(lds + RT_RS); float* lg = (float*)(lds + RT_LG);
    for (int u = c; u < NTOK / 32; u += G) {
        const int t0 = u * 32, b = t0 >> 12;
        const float* ab = AB + b * 2048; const float* sh = mod + b * NMOD + 3 * D;
        f32x4 acc[2][5];
#pragma unroll
        for (int tt = 0; tt < 2; ++tt)
#pragma unroll
            for (int ot = 0; ot < 5; ++ot) acc[tt][ot] = (f32x4){0.f, 0.f, 0.f, 0.f};
        float ssq0 = 0.f, ssq1 = 0.f;
        __syncthreads();
        f32x4 xa[4], ca[2]; u32x4 wa[10];
#define RT_LOAD(X, C, W, ks_) do { const int k0_ = wid * 256 + (ks_) * 32 + 8 * fq; C[0] = *(const f32x4*)(ab + k0_); C[1] = *(const f32x4*)(ab + k0_ + 4); \
            _Pragma("unroll") for (int tt = 0; tt < 2; ++tt) { const float* xp = P.out + (size_t)(t0 + tt * 16 + l16) * D + k0_; X[tt * 2] = *(const f32x4*)xp; X[tt * 2 + 1] = *(const f32x4*)(xp + 4); } \
            _Pragma("unroll") for (int ot = 0; ot < 5; ++ot) { W[ot * 2] = *(const u32x4*)(WRH + (size_t)(ot * 16 + l16) * 2048 + k0_); W[ot * 2 + 1] = *(const u32x4*)(WRL + (size_t)(ot * 16 + l16) * 2048 + k0_); } } while (0)
#define RT_COMP(X, C, W) do { bf16x8 ah[2], al[2]; \
            _Pragma("unroll") for (int tt = 0; tt < 2; ++tt) { const f32x4 x0 = X[tt * 2], x1 = X[tt * 2 + 1]; \
                const float q = (x0[0] * x0[0] + x0[1] * x0[1]) + (x0[2] * x0[2] + x0[3] * x0[3]) + (x1[0] * x1[0] + x1[1] * x1[1]) + (x1[2] * x1[2] + x1[3] * x1[3]); \
                if (tt == 0) ssq0 += q; else ssq1 += q; \
                const f32x4 v0 = x0 * C[0], v1 = x1 * C[1]; u32x4 hb, lb; \
                hb[0] = cvtpk(v0[0], v0[1]); hb[1] = cvtpk(v0[2], v0[3]); hb[2] = cvtpk(v1[0], v1[1]); hb[3] = cvtpk(v1[2], v1[3]); \
                lb[0] = cvtpk(v0[0] - bflo(hb[0]), v0[1] - bfhi(hb[0])); lb[1] = cvtpk(v0[2] - bflo(hb[1]), v0[3] - bfhi(hb[1])); \
                lb[2] = cvtpk(v1[0] - bflo(hb[2]), v1[1] - bfhi(hb[2])); lb[3] = cvtpk(v1[2] - bflo(hb[3]), v1[3] - bfhi(hb[3])); \
                ah[tt] = *reinterpret_cast<bf16x8*>(&hb); al[tt] = *reinterpret_cast<bf16x8*>(&lb); } \
            _Pragma("unroll") for (int ot = 0; ot < 5; ++ot) { const bf16x8 bh = *reinterpret_cast<const bf16x8*>(&W[ot * 2]), bl = *reinterpret_cast<const bf16x8*>(&W[ot * 2 + 1]); \
                _Pragma("unroll") for (int tt = 0; tt < 2; ++tt) { acc[tt][ot] = __builtin_amdgcn_mfma_f32_16x16x32_bf16(ah[tt], bh, acc[tt][ot], 0, 0, 0); \
                    acc[tt][ot] = __builtin_amdgcn_mfma_f32_16x16x32_bf16(ah[tt], bl, acc[tt][ot], 0, 0, 0); acc[tt][ot] = __builtin_amdgcn_mfma_f32_16x16x32_bf16(al[tt], bh, acc[tt][ot], 0, 0, 0); } } } while (0)
#pragma unroll 1
        for (int ks = 0; ks < 8; ++ks) {
            RT_LOAD(xa, ca, wa, ks); __builtin_amdgcn_sched_barrier(0);
            RT_COMP(xa, ca, wa); __builtin_amdgcn_sched_barrier(0);
        }
#undef RT_LOAD
#undef RT_COMP
#pragma unroll
        for (int tt = 0; tt < 2; ++tt)
#pragma unroll
            for (int ot = 0; ot < 5; ++ot)
#pragma unroll
                for (int r = 0; r < 4; ++r) part[(wid * 32 + tt * 16 + 4 * fq + r) * 81 + ot * 16 + l16] = acc[tt][ot][r];
        ssq0 += __shfl_xor(ssq0, 16); ssq0 += __shfl_xor(ssq0, 32); ssq1 += __shfl_xor(ssq1, 16); ssq1 += __shfl_xor(ssq1, 32);
        if (fq == 0) { ssqp[wid * 32 + l16] = ssq0; ssqp[wid * 32 + 16 + l16] = ssq1; }
        __syncthreads();
        if (tid < 32) { float q = 0.f;
#pragma unroll
            for (int w = 0; w < 8; ++w) q += ssqp[w * 32 + tid];
            rs[tid] = rsqrtf(q * (1.f / 2048.f) + EPS); }
        __syncthreads();
        for (int i = tid; i < 32 * 72; i += 512) { const int tk = i / 72, o = i - tk * 72; float q = 0.f;
#pragma unroll
            for (int w = 0; w < 8; ++w) q += part[(w * 32 + tk) * 81 + o];
            lg[tk * 81 + o] = q * rs[tk] + SHW[b * 96 + o] + (o < 8 ? P.b_rg[o] : P.b_re[o - 8]); }
        __syncthreads();
        if (tid < 32) { const float* l = lg + tid * 81; const int t = t0 + tid;
            int gi = 0; float gm = l[0]; for (int j = 1; j < 8; ++j) if (l[j] > gm) { gm = l[j]; gi = j; }
            float gsum = 0.f; for (int j = 0; j < 8; ++j) gsum += expf(l[j] - gm); const float gp = 1.f / gsum;
            const float* el = l + 8 + gi * 8;
            int i0 = 0; float m0 = el[0]; for (int j = 1; j < 8; ++j) if (el[j] > m0) { m0 = el[j]; i0 = j; }
            int i1 = -1; float m1 = -1e30f; for (int j = 0; j < 8; ++j) if (j != i0 && el[j] > m1) { m1 = el[j]; i1 = j; }
            const float rr = expf(m1 - m0), p0 = 1.f / (1.f + rr), p1 = rr / (1.f + rr);
            const int e0 = gi * 8 + i0, e1 = gi * 8 + i1;
            const int q0 = atomicAdd(&cnt[e0 * 64], 1), q1 = atomicAdd(&cnt[e1 * 64], 1);
            toke[t * 2] = e0; toke[t * 2 + 1] = e1; tokp[t * 2] = q0; tokp[t * 2 + 1] = q1;
            sltok[e0 * ECAP + q0] = t; sltok[e1 * ECAP + q1] = t; slw[e0 * ECAP + q0] = gp * p0; slw[e1 * ECAP + q1] = gp * p1; }
        { int laneH = lane; asm volatile("" : "+v"(laneH));
          unsigned char* HM8 = (unsigned char*)HM;
          f32x4 av[8], sv[8];
#pragma unroll
          for (int it = 0; it < 2; ++it)
#pragma unroll
              for (int j = 0; j < 4; ++j) { const int col = it * 1024 + laneH * 16 + 4 * j; av[it * 4 + j] = *(const f32x4*)(ab + col); sv[it * 4 + j] = *(const f32x4*)(sh + col); }
#pragma unroll
          for (int q2 = 0; q2 < 2; ++q2) { f32x4 xv[2][8];
#pragma unroll
            for (int qq = 0; qq < 2; ++qq) { const float* src = P.out + (size_t)(t0 + wid * 4 + q2 * 2 + qq) * D;
#pragma unroll
                for (int it = 0; it < 2; ++it)
#pragma unroll
                    for (int j = 0; j < 4; ++j) xv[qq][it * 4 + j] = *(const f32x4*)(src + it * 1024 + laneH * 16 + 4 * j); }
            __builtin_amdgcn_sched_barrier(0);
#pragma unroll
            for (int qq = 0; qq < 2; ++qq) { const int tk = wid * 4 + q2 * 2 + qq; const float rstd = rs[tk]; unsigned char* dst = HM8 + (size_t)(t0 + tk) * HMLD;
#pragma unroll
                for (int it = 0; it < 2; ++it) { u32x4 w;
#pragma unroll
                    for (int j = 0; j < 4; ++j) { const f32x4 o = xv[qq][it * 4 + j] * rstd * av[it * 4 + j] + sv[it * 4 + j];
                        int p_ = __builtin_amdgcn_cvt_pk_fp8_f32(o[0], o[1], 0, false); p_ = __builtin_amdgcn_cvt_pk_fp8_f32(o[2], o[3], p_, true); w[j] = (unsigned)p_; }
                    *(u32x4*)(dst + it * 1024 + laneH * 16) = w; } }
            __builtin_amdgcn_sched_barrier(0); } }
    }
}
__device__ __forceinline__ void combine(float* out, float* dst, const float* mod, const bf16_t* YS, const int* cnt, const int* toke, const int* tokp, char* lds, int c, int G) {
    int* base = (int*)lds; int tid = threadIdx.x; asm volatile("" : "+v"(tid)); const int lane = tid & 63;
    __syncthreads();
    if (tid < 64) { int s = 0; for (int i = 0; i < tid; ++i) s += cnt[i * 64]; base[tid] = s; }
    __syncthreads();
    for (int t = c * 8 + (tid >> 6); t < NTOK; t += G * 8) {
        const int2 te = *(const int2*)(toke + t * 2), tp = *(const int2*)(tokp + t * 2);
        const int s0 = base[te.x] + tp.x, s1 = base[te.y] + tp.y;
        const float* gt = mod + (t >> 12) * NMOD + 5 * D;
        u32x4 a[4], b2[4]; f32x4 o0[4], o1[4], g0[4], g1[4];
#pragma unroll
        for (int it = 0; it < 4; ++it) { const int col = it * 512 + lane * 8; const float* op = out + (size_t)t * D + col;
            a[it] = *(const u32x4*)(YS + (size_t)s0 * D + col); b2[it] = *(const u32x4*)(YS + (size_t)s1 * D + col);
            o0[it] = *(const f32x4*)op; o1[it] = *(const f32x4*)(op + 4); g0[it] = *(const f32x4*)(gt + col); g1[it] = *(const f32x4*)(gt + col + 4); }
#pragma unroll
        for (int it = 0; it < 4; ++it) { const int col = it * 512 + lane * 8; float* op = dst + (size_t)t * D + col;
            f32x4 p0 = o0[it], p1 = o1[it];
            p0[0] += g0[it][0] * (bflo(a[it][0]) + bflo(b2[it][0])); p0[1] += g0[it][1] * (bfhi(a[it][0]) + bfhi(b2[it][0])); p0[2] += g0[it][2] * (bflo(a[it][1]) + bflo(b2[it][1])); p0[3] += g0[it][3] * (bfhi(a[it][1]) + bfhi(b2[it][1]));
            p1[0] += g1[it][0] * (bflo(a[it][2]) + bflo(b2[it][2])); p1[1] += g1[it][1] * (bfhi(a[it][2]) + bfhi(b2[it][2])); p1[2] += g1[it][2] * (bflo(a[it][3]) + bflo(b2[it][3])); p1[3] += g1[it][3] * (bfhi(a[it][3]) + bfhi(b2[it][3]));
            *(f32x4*)op = p0; *(f32x4*)(op + 4) = p1; }
    }
}


template <int NS, int SEG>
__device__ __forceinline__ void bstream_probe(const float* wg, const float* wu, char* lds, int c) {
    using u32x4 = __attribute__((ext_vector_type(4))) unsigned;
    const int tid = threadIdx.x, wid = __builtin_amdgcn_readfirstlane(tid >> 6), half = wid >> 2, tq = tid & 255, ng = tq & 15, kq = tq >> 4;
    unsigned sink = 0;
    for (int idx = c >> 3; idx < 96; idx += 32) { const int e = (c & 7) + 8 * (idx / 12), j = idx % 12;
        const float* W = SEG == 0 ? (half ? wu : wg) + (size_t)e * 2048 * 768 + j * 64 : ((j & 1) ? wu : wg) + (size_t)e * 2048 * 768 + (j >> 1) * 128 + half * 64;
        const __amdgpu_buffer_rsrc_t rs = __builtin_amdgcn_make_buffer_rsrc((void*)W, (short)0, 2048 * 768 * 4, 0x00020000);
        const unsigned boff = (unsigned)((4 * kq) * 768 + 4 * ng) * 4u;
        u32x4 st[NS][4];
#pragma unroll
        for (int s2 = 0; s2 < NS; ++s2)
#pragma unroll
            for (int jj = 0; jj < 4; ++jj) st[s2][jj] = __builtin_amdgcn_raw_buffer_load_b128(rs, boff, (s2 * 64 + jj) * 3072, 0);
        for (int t = 0; t < 32; t += NS) {
#pragma unroll
            for (int s2 = 0; s2 < NS; ++s2) { unsigned acc = 0;
#pragma unroll
                for (int jj = 0; jj < 4; ++jj) acc ^= st[s2][jj][0] ^ st[s2][jj][1] ^ st[s2][jj][2] ^ st[s2][jj][3];
                *(unsigned*)(lds + ((t + s2) & 1) * 8192 + tid * 4) = acc; sink ^= acc;
                const int kn = ((t + s2 + NS) & 31) * 64;
#pragma unroll
                for (int jj = 0; jj < 4; ++jj) st[s2][jj] = __builtin_amdgcn_raw_buffer_load_b128(rs, boff, (kn + jj) * 3072, 0);
                __syncthreads(); }
        }
        asm volatile("s_waitcnt vmcnt(0)" ::: "memory");
    }
    if (sink == 0x12345u) *(unsigned*)(lds) = sink;
}
template <int LO, int HI>
__global__ __launch_bounds__(512, 2) void mk_fwd(Params P) {
    extern __shared__ __attribute__((aligned(16))) unsigned char shm[];
    char* lds = (char*)shm + LDS_PH; char* ws = P.ws;
    const int c = (int)blockIdx.x, G = (int)gridDim.x;
    unsigned* bar = (unsigned*)(ws + WS_CTL); int* CNT = (int*)(ws + WS_CTL) + 4096; float* MOD = (float*)(ws + WS_MOD);
    bf16_t* WinT = (bf16_t*)(ws + WS_WINT); bf16_t* WuqT = (bf16_t*)(ws + WS_WUQT); bf16_t* WukvT = (bf16_t*)(ws + WS_WUKVT); bf16_t* WoutT = (bf16_t*)(ws + WS_WOUTT);
    bf16_t* HX = (bf16_t*)(ws + WS_HX); bf16_t* Gb = (bf16_t*)(ws + WS_G); bf16_t* QLb = (bf16_t*)(ws + WS_QL); bf16_t* KVLb = (bf16_t*)(ws + WS_KVL); bf16_t* RK = (bf16_t*)(ws + WS_ROPEK);
    bf16_t* QRAW = (bf16_t*)(ws + WS_QRAW); bf16_t* KNRAW = (bf16_t*)(ws + WS_KNRAW); bf16_t* Vf = (bf16_t*)(ws + WS_VF); bf16_t* Qf = (bf16_t*)(ws + WS_QF); bf16_t* Kf = (bf16_t*)(ws + WS_KF);
    bf16_t* ATT = (bf16_t*)(ws + WS_ATT); bf16_t* T1 = (bf16_t*)(ws + WS_T1); bf16_t* Y = (bf16_t*)(ws + WS_Y); bf16_t* MIXA = (bf16_t*)(ws + WS_MIXA); bf16_t* HM = (bf16_t*)(ws + WS_HM);
    int* TOKE = (int*)(ws + WS_TOKE); int* TOKP = (int*)(ws + WS_TOKP); int* SLTOK = (int*)(ws + WS_SLTOK); float* SLW = (float*)(ws + WS_SLW);
    bf16_t* H = (bf16_t*)(ws + WS_H); bf16_t* YS = (bf16_t*)(ws + WS_YS); float* SSQP = (float*)(ws + WS_SSQP);
    bf16_t* WF = (bf16_t*)(ws + WS_WF); bf16_t* MT = (bf16_t*)(ws + WS_MT); float* WR = (float*)(ws + WS_WR);
    XcdBarrier xb;
    if constexpr (HI - LO > 1) {
        if (threadIdx.x == 0) *(uint4*)(shm + LDS_XB) = make_uint4(0u, 0u, 0u, 0u);
        __syncthreads();
        xb = xcd_barrier_post(bar, (volatile LAS unsigned*)(shm + LDS_XB));
    }
#define MK_PHASE(p) if constexpr (LO <= (p) && (p) < HI)
#define MK_SEAM(p) if constexpr (LO <= (p) && (p) + 1 < HI) xcd_barrier(xb)
    MK_PHASE(0) { for (int u = c; u < 192; u += G) ada_unit(P, MOD, u, lds); p0_jobs(P, lds, c, G); }
    MK_SEAM(0);
    MK_PHASE(1) {
        if (c < 64) { pg8::OrdOne S; S.pm = (c & 15) >> 3; S.pn = c & 7; const int g = c >> 4;
            pg8::gemm_phase<pg8::EpiFold, pg8::OrdOne, false>((PG8_LAS unsigned char*)lds, pg8::Gemm{MT, WF + g * 256, 512, 2048, 256, 256, 1024, 0}, S, pg8::EpiFold{WinT, g, 0}, nullptr); }
        if (G == 256) { if (c < 64) hx_rows(P, MOD, HX, c, 448); else { hx_rows(P, MOD, HX, 64 + 2 * (c - 64), 448); hx_rows(P, MOD, HX, 65 + 2 * (c - 64), 448); } }
        else hx_rows(P, MOD, HX, c, G); }
    MK_SEAM(1);
    MK_PHASE(2) { pg8::OrdInproj S; S.G = G; S.c = c; pg8::gemm_phase<pg8::EpiInproj, pg8::OrdInproj, false>((PG8_LAS unsigned char*)lds, pg8::Gemm{HX, WinT, NROW, WIN_ROWS, D, D, D, 0}, S, pg8::EpiInproj{Gb, QLb, KVLb, RK, SSQP}, nullptr);
        if (G == 256) { if (c >= 198) tcvt_tiles(P, ws, lds, 1216 + (c - 198), 58, 2240); } else tcvt_tiles(P, ws, lds, 1216 + c, G, 2240); }
    MK_SEAM(2);
    MK_PHASE(3) {
        { pg8::OrdGrid S; S.nM = 32; S.nN = 6; S.G = G; S.c = c; if (c < 192) pg8::gemm_phase<pg8::EpiQ, pg8::OrdGrid, false>((PG8_LAS unsigned char*)lds, pg8::Gemm{QLb, WuqT, NTOK, 1536, 768, 768, 768, 0}, S, pg8::EpiQ{QRAW, SSQP}, nullptr); }
        __syncthreads();
        { pg8::OrdKV S; S.c = c; pg8::gemm_phase<pg8::EpiKV, pg8::OrdKV, false>((PG8_LAS unsigned char*)lds, pg8::Gemm{KVLb, WukvT, NROW, 2048, 512, 512, 512, 0}, S, pg8::EpiKV{KNRAW, Vf, SSQP}, nullptr); } }
    MK_SEAM(3);
    MK_PHASE(4) { qkprep(P, QRAW, KNRAW, RK, Qf, Kf, lds, c, G); dft::phase<1>(Gb, T1, lds, c, G); }
    MK_SEAM(4);
    MK_PHASE(5) { dft::phase<2>(T1, Y, lds, c, G); __syncthreads(); attn_phase(Qf, Kf, Vf, ATT, lds, c, G, P.w_gate, P.w_up, (unsigned char*)(ws + WS_SC) + (64u << 20)); }
    MK_SEAM(5);
    MK_PHASE(6) { mixnorm(Y, ATT, MIXA, c, G); route_consts(P, MOD, WR, (float*)(ws + WS_AB), (float*)(ws + WS_SHW), c, G); }
    MK_SEAM(6);
    MK_PHASE(7) { pg8::OrdGrid S; S.nM = 32; S.nN = 8; S.G = G; S.c = c; pg8::gemm_phase<pg8::EpiOut, pg8::OrdGrid, false>((PG8_LAS unsigned char*)lds, pg8::Gemm{MIXA, WoutT, NTOK, D, 2048, 2048, 2048, 0}, S, pg8::EpiOut{P.out, P.x, MOD}, nullptr); }
    MK_SEAM(7);
    MK_PHASE(8) { route(P, MOD, (const float*)(ws + WS_AB), (const float*)(ws + WS_SHW), (const bf16_t*)(ws + WS_WRH), (const bf16_t*)(ws + WS_WRL), HM, CNT, TOKE, TOKP, SLTOK, SLW, lds, c, G); }
    MK_SEAM(8);
    MK_PHASE(9) { moe::moe_phase<0>((const unsigned char*)HM, SLTOK, nullptr, P.w_gate, P.w_up, (void*)H, CNT, lds, c, G, (const unsigned char*)(ws + WS_SC) + (64u << 20)); }
    MK_SEAM(9);
    MK_PHASE(10) { moe::moe_phase<1>((const unsigned char*)H, nullptr, SLW, P.w_down, nullptr, (void*)YS, CNT, lds, c, G); }
    MK_SEAM(10);
    MK_PHASE(11) { combine(P.out, P.out, MOD, YS, CNT, TOKE, TOKP, lds, c, G); }
    MK_PHASE(12) { qkprep(P, QRAW, KNRAW, RK, Qf, Kf, lds, c, G); }
    MK_PHASE(13) { dft::phase<1>(Gb, T1, lds, c, G); }
    MK_PHASE(14) { dft::phase<2>(T1, Y, lds, c, G); }
    MK_PHASE(15) { attn_phase(Qf, Kf, Vf, ATT, lds, c, G, P.w_gate, P.w_up, (unsigned char*)(ws + WS_SC) + (64u << 20)); }
    MK_PHASE(16) { hx_rows(P, MOD, HX, c, G); }
    MK_PHASE(17) { for (int u = c; u < 192; u += G) ada_unit(P, MOD, u, lds); }
    MK_PHASE(20) { moe::moe_phase<0, 1>((const unsigned char*)HM, SLTOK, nullptr, P.w_gate, P.w_up, (void*)H, CNT, lds, c, G); }
    MK_PHASE(21) { moe::moe_phase<0, 2>((const unsigned char*)HM, SLTOK, nullptr, P.w_gate, P.w_up, (void*)H, CNT, lds, c, G); }
    MK_PHASE(22) { moe::moe_phase<0, 3>((const unsigned char*)HM, SLTOK, nullptr, P.w_gate, P.w_up, (void*)H, CNT, lds, c, G); }
    MK_PHASE(23) { moe::moe_phase<0, 4>((const unsigned char*)HM, SLTOK, nullptr, P.w_gate, P.w_up, (void*)H, CNT, lds, c, G); }
    MK_PHASE(25) { bstream_probe<2, 0>(P.w_gate, P.w_up, lds, c); }
    MK_PHASE(26) { bstream_probe<4, 0>(P.w_gate, P.w_up, lds, c); }
    MK_PHASE(27) { bstream_probe<8, 0>(P.w_gate, P.w_up, lds, c); }
    MK_PHASE(28) { bstream_probe<4, 1>(P.w_gate, P.w_up, lds, c); }
    MK_PHASE(24) { moe::moe_phase<0, 8>((const unsigned char*)HM, SLTOK, nullptr, P.w_gate, P.w_up, (void*)H, CNT, lds, c, G); }
    MK_PHASE(18) { char* sc = ws + WS_SC; route(P, MOD, (const float*)(ws + WS_AB), (const float*)(ws + WS_SHW), (const bf16_t*)(ws + WS_WRH), (const bf16_t*)(ws + WS_WRL), (bf16_t*)(sc + (64u << 20)), (int*)sc, (int*)(sc + (1u << 20)), (int*)(sc + (2u << 20)), (int*)(sc + (4u << 20)), (float*)(sc + (8u << 20)), lds, c, G); }
    MK_PHASE(19) { combine(P.out, (float*)(ws + WS_SC), MOD, YS, CNT, TOKE, TOKP, lds, c, G); }
#undef MK_PHASE
#undef MK_SEAM
}
}
}

#ifndef MK_MODE
#define MK_MODE 2
#endif
template <int LO, int HI> static bool mk_launch(const mk::Params& P, int grid, hipStream_t stream) {
    static int ok = 0;
    if (!ok) { if (hipFuncSetAttribute((const void*)mk::mk_fwd<LO, HI>, hipFuncAttributeMaxDynamicSharedMemorySize, mk::LDS_TOTAL) != hipSuccess) { fprintf(stderr, "kernel_launch: hipFuncSetAttribute failed\n"); return false; } ok = 1; }
    hipLaunchKernelGGL((mk::mk_fwd<LO, HI>), dim3(grid), dim3(512), mk::LDS_TOTAL, stream, P);
    const hipError_t e = hipPeekAtLastError(); if (e != hipSuccess) { fprintf(stderr, "kernel_launch: launch [%d,%d) failed: %s\n", LO, HI, hipGetErrorName(e)); return false; }
    return true;
}
extern "C" void kernel_launch(void* const* d_in, const int* in_sizes, int n_in, void* d_out, int out_size, void* d_ws, size_t ws_size, hipStream_t stream) {
    if (n_in != 25 || out_size != NTOK * D || ws_size < WS_END) { fprintf(stderr, "kernel_launch: unexpected shapes (n_in %d out %d ws %zu need %zu)\n", n_in, out_size, ws_size, (size_t)WS_END); return; }
    mk::Params P{};
    const float** pf = (const float**)&P;
    for (int i = 0; i < 25; ++i) pf[i] = (const float*)d_in[i];
    P.out = (float*)d_out; P.ws = (char*)d_ws;
    static int grid = 0;
    if (!grid) { int dev = 0, cus = 0; if (hipGetDevice(&dev) != hipSuccess || hipDeviceGetAttribute(&cus, hipDeviceAttributeMultiprocessorCount, dev) != hipSuccess || cus < 1) { fprintf(stderr, "kernel_launch: device query failed\n"); return; }
        grid = cus; }
    if (hipMemsetAsync((char*)d_ws + WS_CTL, 0, 65536, stream) != hipSuccess) { fprintf(stderr, "kernel_launch: memset failed\n"); return; }
#if MK_MODE == 2
    mk_launch<0, 12>(P, grid, stream);
#ifdef MK_PROBE_EXTRA
    MK_PROBE_EXTRA
#endif
#else
    mk_launch<0, 1>(P, grid, stream) && mk_launch<1, 2>(P, grid, stream) && mk_launch<2, 3>(P, grid, stream) && mk_launch<3, 4>(P, grid, stream) && mk_launch<4, 5>(P, grid, stream) && mk_launch<5, 6>(P, grid, stream) &&
    mk_launch<6, 7>(P, grid, stream) && mk_launch<7, 8>(P, grid, stream) && mk_launch<8, 9>(P, grid, stream) && mk_launch<9, 10>(P, grid, stream) && mk_launch<10, 11>(P, grid, stream) && mk_launch<11, 12>(P, grid, stream);
#endif
}
#if 0
extern "C" void kernel_launch(void* const* d_in, const int* in_sizes, int n_in, void* d_out, int out_size, void* d_ws, size_t ws_size, hipStream_t stream) {
    if (n_in != 25 || out_size != NTOK * D || ws_size < WS_END) { fprintf(stderr, "kernel_launch: unexpected shapes (n_in %d out %d ws %zu need %zu)\n", n_in, out_size, ws_size, (size_t)WS_END); return; }
    const float* x = (const float*)d_in[0]; const float* c = (const float*)d_in[1]; const float* ctx = (const float*)d_in[2]; const float* cctx = (const float*)d_in[3];
    const float* w_ada = (const float*)d_in[4]; const float* b_ada = (const float*)d_in[5]; const float* g1 = (const float*)d_in[6]; const float* g2 = (const float*)d_in[7];
    const float* w_in = (const float*)d_in[8]; const float* g_q_a = (const float*)d_in[9]; const float* g_kv_a = (const float*)d_in[10]; const float* w_uq = (const float*)d_in[11];
    const float* w_ukv = (const float*)d_in[12]; const float* g_qk_q = (const float*)d_in[13]; const float* g_qk_k = (const float*)d_in[14]; const float* g_of = (const float*)d_in[15];
    const float* g_oa = (const float*)d_in[16]; const float* w_out = (const float*)d_in[17]; const float* w_rg = (const float*)d_in[18]; const float* b_rg = (const float*)d_in[19];
    const float* w_re = (const float*)d_in[20]; const float* b_re = (const float*)d_in[21]; const float* w_gate = (const float*)d_in[22]; const float* w_up = (const float*)d_in[23];
    const float* w_down = (const float*)d_in[24];
    float* out = (float*)d_out; char* ws = (char*)d_ws;
    int* CNT = (int*)(ws + WS_CTL); float* MOD = (float*)(ws + WS_MOD);
    bf16_t* WinT = (bf16_t*)(ws + WS_WINT); bf16_t* WuqT = (bf16_t*)(ws + WS_WUQT); bf16_t* WukvT = (bf16_t*)(ws + WS_WUKVT); bf16_t* WoutT = (bf16_t*)(ws + WS_WOUTT);
    bf16_t* HX = (bf16_t*)(ws + WS_HX); bf16_t* G = (bf16_t*)(ws + WS_G); bf16_t* QLb = (bf16_t*)(ws + WS_QL); bf16_t* KVLb = (bf16_t*)(ws + WS_KVL); bf16_t* RK = (bf16_t*)(ws + WS_ROPEK);
    float* RSTDQ = (float*)(ws + WS_RSTDQ); float* RSTDKV = (float*)(ws + WS_RSTDKV);
    bf16_t* QRAW = (bf16_t*)(ws + WS_QRAW); bf16_t* KNRAW = (bf16_t*)(ws + WS_KNRAW); bf16_t* Vf = (bf16_t*)(ws + WS_VF); bf16_t* Qf = (bf16_t*)(ws + WS_QF); bf16_t* Kf = (bf16_t*)(ws + WS_KF);
    bf16_t* ATT = (bf16_t*)(ws + WS_ATT); bf16_t* T1 = (bf16_t*)(ws + WS_T1); bf16_t* Y = (bf16_t*)(ws + WS_Y); bf16_t* MIXA = (bf16_t*)(ws + WS_MIXA); bf16_t* HM = (bf16_t*)(ws + WS_HM);
    int* TOKE = (int*)(ws + WS_TOKE); int* TOKP = (int*)(ws + WS_TOKP); int* SLTOK = (int*)(ws + WS_SLTOK); float* SLW = (float*)(ws + WS_SLW);
    bf16_t* H = (bf16_t*)(ws + WS_H); bf16_t* YS = (bf16_t*)(ws + WS_YS); float* SC = (float*)(ws + WS_SC); float* SSQP = (float*)(ws + WS_SSQP);

    (void)hipMemsetAsync(ws + WS_CTL, 0, 65536, stream);
    (void)hipMemsetAsync(WinT + (size_t)3392 * D, 0, (size_t)192 * D * 2, stream);
    k_ada<<<dim3(NMOD / 256, 3), 256, 0, stream>>>(c, cctx, w_ada, b_ada, MOD);
    k_fold<<<2048, 256, 0, stream>>>(w_in, WinT);
    k_tcvt<<<dim3(1344 / 32, D / 32), 256, 0, stream>>>(w_in, nullptr, nullptr, WinT + (size_t)2048 * D, INP, 1024, D, 1344, 0, D);
    k_tcvt<<<dim3(1536 / 32, 768 / 32), 256, 0, stream>>>(w_uq, g_q_a, g_q_a, WuqT, 1536, 0, 768, 1536, 768, 768);
    k_tcvt<<<dim3(2048 / 32, 512 / 32), 256, 0, stream>>>(w_ukv, g_kv_a, g_kv_a, WukvT, 2048, 0, 512, 2048, 512, 512);
    k_tcvt<<<dim3(2048 / 32, 2048 / 32), 256, 0, stream>>>(w_out, g_of, g_oa, WoutT, 2048, 0, 2048, 2048, 1024, 2048);
    k_hx<<<NROW / 4, 256, 0, stream>>>(x, ctx, g1, MOD, HX);
    static int attr_ok = 0;
    if (!attr_ok) {
        if (hipFuncSetAttribute((const void*)k_g_inproj, hipFuncAttributeMaxDynamicSharedMemorySize, pg8::STAGE_BYTES) != hipSuccess ||
            hipFuncSetAttribute((const void*)k_g_qkv, hipFuncAttributeMaxDynamicSharedMemorySize, pg8::STAGE_BYTES) != hipSuccess ||
            hipFuncSetAttribute((const void*)k_g_out, hipFuncAttributeMaxDynamicSharedMemorySize, pg8::STAGE_BYTES) != hipSuccess ||
            hipFuncSetAttribute((const void*)k_attn, hipFuncAttributeMaxDynamicSharedMemorySize, att::SHM_ATTN) != hipSuccess ||
            hipFuncSetAttribute((const void*)k_moe_up_opt, hipFuncAttributeMaxDynamicSharedMemorySize, moe::LDS_BYTES) != hipSuccess ||
            hipFuncSetAttribute((const void*)k_moe_down_opt, hipFuncAttributeMaxDynamicSharedMemorySize, moe::LDS_BYTES) != hipSuccess) { fprintf(stderr, "hipFuncSetAttribute failed\n"); return; }
        attr_ok = 1; }
#if OPT_INPROJ
    k_g_inproj<<<256, 512, pg8::STAGE_BYTES, stream>>>(pg8::Gemm{HX, WinT, NROW, WIN_ROWS, D, D, D, 0}, pg8::EpiInproj{G, QLb, KVLb, RK, SSQP});
    k_rstd2<<<NROW / 256, 256, 0, stream>>>(SSQP, RSTDQ, RSTDKV);
#else
    gemm_naive<true><<<dim3(3392 / 64, NROW / 64, 1), 256, 0, stream>>>(NROW, 3392, D, 0, LdBf{HX, 0, D}, LdBfT{WinT, 0, D}, StInproj{G, QLb, KVLb, RK});
    k_rstd<<<NROW / 256, 256, 0, stream>>>(QLb, KVLb, RSTDQ, RSTDKV, SSQP);
#endif
#if OPT_QKV
    k_g_qkv<<<256, 512, pg8::STAGE_BYTES, stream>>>(pg8::Gemm{QLb, WuqT, NTOK, 1536, 768, 768, 768, 0}, pg8::EpiQ{QRAW, SSQP}, pg8::Gemm{KVLb, WukvT, NROW, 2048, 512, 512, 512, 0}, pg8::EpiKV{KNRAW, Vf, SSQP});
#else
    gemm_naive<true><<<dim3(1536 / 64, NTOK / 64, 1), 256, 0, stream>>>(NTOK, 1536, 768, 0, LdBf{QLb, 0, 768}, LdBfT{WuqT, 0, 768}, StQ{QRAW, RSTDQ});
    gemm_naive<true><<<dim3(2048 / 64, NROW / 64, 1), 256, 0, stream>>>(NROW, 2048, 512, 0, LdBf{KVLb, 0, 512}, LdBfT{WukvT, 0, 512}, StKV{KNRAW, Vf, RSTDKV});
#endif
    k_qkprep<<<(NTOK * NH + NROW * NH + 255) / 256, 256, 0, stream>>>(QRAW, KNRAW, RK, g_qk_q, g_qk_k, Qf, Kf);
#if OPT_ATTN
    k_attn<<<256, 512, att::SHM_ATTN, stream>>>(Qf, Kf, Vf, ATT);
#else
    for (int b = 0; b < 2; ++b) {
        gemm_naive<true><<<dim3(NKEY / 64, SEQ / 64, NH), 256, 0, stream>>>(SEQ, NKEY, HQK, 0, LdBf{Qf + (size_t)b * NH * SEQ * HQK, (size_t)SEQ * HQK, HQK}, LdBfT{Kf + (size_t)b * NH * NKEY * HQK, (size_t)NKEY * HQK, HQK}, StF{SC, (size_t)SEQ * NKEY, NKEY});
        k_softmax<<<NH * SEQ / 4, 256, 0, stream>>>(SC);
        gemm_naive<false><<<dim3(HV / 64, SEQ / 64, NH), 256, 0, stream>>>(SEQ, HV, NKEY, 0, LdF{SC, (size_t)SEQ * NKEY, NKEY}, LdBf{Vf + (size_t)b * NH * NKEY * HV, (size_t)NKEY * HV, HV}, StAtt{ATT, b});
    }
#endif
    k_dft1<<<dim3(4, SEQ, 2), 256, 0, stream>>>(G, T1);
    k_dft2<<<dim3(4, SEQ, 2), 256, 0, stream>>>(T1, Y);
    k_mixnorm<<<NTOK / 4, 256, 0, stream>>>(Y, ATT, MIXA);
#if OPT_OUT
    k_g_out<<<256, 512, pg8::STAGE_BYTES, stream>>>(pg8::Gemm{MIXA, WoutT, NTOK, D, 2048, 2048, 2048, 0}, pg8::EpiOut{out, x, MOD});
#else
    gemm_naive<true><<<dim3(D / 64, NTOK / 64, 1), 256, 0, stream>>>(NTOK, D, 2048, 0, LdBf{MIXA, 0, 2048}, LdBfT{WoutT, 0, 2048}, StOut{out, x, MOD});
#endif
    k_route<<<NTOK, 256, 0, stream>>>(out, g2, MOD, w_rg, b_rg, w_re, b_re, HM, CNT, TOKE, TOKP, SLTOK, SLW);
#if OPT_MOE
    k_moe_up_opt<<<256, 512, moe::LDS_BYTES, stream>>>(HM, SLTOK, w_gate, w_up, H, CNT);
#else
    k_moe_up<<<dim3(DE / 64, ECAP / 64, NEXP), 256, 0, stream>>>(HM, w_gate, w_up, CNT, SLTOK, H);
#endif
#if OPT_MOE
    k_moe_down_opt<<<256, 512, moe::LDS_BYTES, stream>>>(H, SLW, w_down, YS, CNT);
#else
    k_moe_down<<<dim3(D / 64, ECAP / 64, NEXP), 256, 0, stream>>>(H, w_down, CNT, SLW, YS);
#endif
    k_combine<<<NTOK, 256, 0, stream>>>(out, MOD, YS, CNT, TOKE, TOKP);
}

#endif
```

```cpp
#include <hip/hip_runtime.h>
#include <stdint.h>
#include <stdio.h>

typedef unsigned short bf16_t;
namespace pg8 {
#define PG8_LAS __attribute__((address_space(3)))
typedef short bf16x8 __attribute__((ext_vector_type(8)));
typedef float f32x4 __attribute__((ext_vector_type(4)));
typedef unsigned u32x4 __attribute__((ext_vector_type(4)));
constexpr int BM = 256, BK = 64, HALF = 128, HTB = HALF * BK * 2  , STAGE_BYTES = 8 * HTB, NXCD = 8, WGM = 8;

__host__ __device__ __forceinline__ int lds_byte(int r, int c) { const int st = (r >> 4) * 2 + (c >> 5), rr = r & 15, cc = c & 31, ob = rr * 64 + cc * 2; return st * 1024 + (ob ^ (((ob >> 9) & 1) << 5)); }
__host__ __device__ __forceinline__ void stage_rc(int b, int& R, int& C) { const int st = b / 1024, sb = b % 1024, swz = sb ^ (((sb >> 9) & 1) << 5); R = (st >> 1) * 16 + swz / 64; C = (st & 1) * 32 + (swz % 64) / 2; }
__host__ __device__ __forceinline__ int perm32(int rho) { const int n = rho >> 4, i = rho & 15; return 8 * (i >> 2) + 4 * n + (i & 3); }

struct Unit { int pm, pn; };
struct Gemm { const bf16_t* A; const bf16_t* Bt; int M, N, K, lda, ldb, pad; };

__device__ __forceinline__ unsigned cvt_pk_bf16(float lo, float hi) { unsigned r; asm volatile("v_cvt_pk_bf16_f32 %0, %1, %2" : "=v"(r) : "v"(lo), "v"(hi)); return r; }
struct OrdGrid {
    int nM, nN, G, c;
    __device__ bool next(int i, Unit& u) const {
        const int nwg = nM * nN; const long L = (long)i * G + c; if (L >= nwg) return false;
        int wgid = (int)L; { const int q = nwg / NXCD, r = nwg % NXCD, xcd = wgid % NXCD, off = wgid / NXCD; wgid = (xcd < r ? xcd * (q + 1) : r * (q + 1) + (xcd - r) * q) + off; }
        const int nig = WGM * nN, gid = wgid / nig, fm = gid * WGM, gsz = (nM - fm) < WGM ? (nM - fm) : WGM;
        u.pm = fm + ((wgid % nig) % gsz); u.pn = (wgid % nig) / gsz; return true; }
    __device__ __forceinline__ void a_ready(const Unit&) const {}
    __device__ __forceinline__ void done(const Unit&) const {}
};
struct OrdInproj {
    int G, c;
    __device__ bool next(int i, Unit& u) const {
        const int L = i * G + c; if (L >= 454) return false;
        if (L >= 448) { const int e = L - 448; u.pm = 32 + e / 3; u.pn = 11 + e % 3; return true; }
        const int wgid = (L % NXCD) * 56 + L / NXCD, nig = WGM * 14, gid = wgid / nig;
        u.pm = gid * WGM + ((wgid % nig) % WGM); u.pn = (wgid % nig) / WGM; return true; }
    __device__ __forceinline__ void a_ready(const Unit&) const {}
    __device__ __forceinline__ void done(const Unit&) const {}
};
struct OrdKV {
    int c;
    __device__ bool next(int i, Unit& u) const {
        int L;
        if (c >= 192) { if (i >= 2) return false; L = 2 * (c - 192) + i; }
        else { if (i >= 1 || c >= 144) return false; L = 128 + c; }
        u.pm = L >> 3; u.pn = L & 7; return true; }
    __device__ __forceinline__ void a_ready(const Unit&) const {}
    __device__ __forceinline__ void done(const Unit&) const {}
};
struct EpiInproj { static constexpr bool PERM = true, AFTER_DRAIN = false;
    bf16_t *G, *QLb, *KVLb, *RK; float* SSQP;
    __device__ __forceinline__ void operator()(const f32x4 (&acc)[2][2][4][2], const Unit& u, int wr, int wc, int fr, int fq) const {
        const int pn = u.pn; bf16_t* base; int ldc, colt, sq = -1;
        if (pn < 8) { base = G; ldc = 2048; colt = pn * 256; }
        else if (pn < 11) { base = QLb; ldc = 768; colt = (pn - 8) * 256; sq = (pn - 8) * 4 + wc; }
        else if (pn < 13) { base = KVLb; ldc = 512; colt = (pn - 11) * 256; sq = (pn - 8) * 4 + wc; }
        else { base = RK; ldc = 64; colt = 0; }
        const int row0 = u.pm * BM + wr * 64 + fr, col0 = colt + wc * 32 + 8 * fq;
#pragma unroll
        for (int ai = 0; ai < 2; ++ai)
#pragma unroll
            for (int m = 0; m < 4; ++m) { const int row = row0 + ai * HALF + m * 16; float s = 0.f;
#pragma unroll
                for (int bj = 0; bj < 2; ++bj) { const f32x4 v0 = acc[ai][bj][m][0], v1 = acc[ai][bj][m][1];
                    u32x4 w; w.x = cvt_pk_bf16(v0[0], v0[1]); w.y = cvt_pk_bf16(v0[2], v0[3]); w.z = cvt_pk_bf16(v1[0], v1[1]); w.w = cvt_pk_bf16(v1[2], v1[3]);
                    if (pn < 13 || (bj == 0 && wc < 2)) *(u32x4*)(base + (size_t)row * ldc + col0 + bj * HALF) = w;
                    s += (v0[0] * v0[0] + v0[1] * v0[1]) + (v0[2] * v0[2] + v0[3] * v0[3]) + (v1[0] * v1[0] + v1[1] * v1[1]) + (v1[2] * v1[2] + v1[3] * v1[3]); }
                if (sq >= 0) { s += __shfl_xor(s, 16); s += __shfl_xor(s, 32); if (fq == 0) SSQP[(size_t)row * 20 + sq] = s; } }
    }
};
struct EpiQ { static constexpr bool PERM = true, AFTER_DRAIN = false;
    bf16_t* Q; const float* SSQP;
    __device__ __forceinline__ void operator()(const f32x4 (&acc)[2][2][4][2], const Unit& u, int wr, int wc, int fr, int fq) const {
        const int row0 = u.pm * BM + wr * 64 + fr, col0 = u.pn * BM + wc * 32 + 8 * fq;
#pragma unroll
        for (int ai = 0; ai < 2; ++ai)
#pragma unroll
            for (int m = 0; m < 4; ++m) { const int row = row0 + ai * HALF + m * 16; const f32x4* sp = (const f32x4*)(SSQP + (size_t)row * 20);
                const f32x4 a = sp[0], b = sp[1], c = sp[2]; const float s = ((a[0] + a[1]) + (a[2] + a[3])) + ((b[0] + b[1]) + (b[2] + b[3])) + ((c[0] + c[1]) + (c[2] + c[3]));
                const float rs = rsqrtf(s * (1.f / 768.f) + 1e-6f);
#pragma unroll
                for (int bj = 0; bj < 2; ++bj) { const f32x4 v0 = acc[ai][bj][m][0] * rs, v1 = acc[ai][bj][m][1] * rs;
                    u32x4 w; w.x = cvt_pk_bf16(v0[0], v0[1]); w.y = cvt_pk_bf16(v0[2], v0[3]); w.z = cvt_pk_bf16(v1[0], v1[1]); w.w = cvt_pk_bf16(v1[2], v1[3]);
                    *(u32x4*)(Q + (size_t)row * 1536 + col0 + bj * HALF) = w; } }
    }
};
struct EpiKV { static constexpr bool PERM = true, AFTER_DRAIN = false;
    bf16_t *KN, *V; const float* SSQP;
    __device__ __forceinline__ void operator()(const f32x4 (&acc)[2][2][4][2], const Unit& u, int wr, int wc, int fr, int fq) const {
        const int row0 = u.pm * BM + wr * 64 + fr, h = u.pn, cw = wc * 32 + 8 * fq;
#pragma unroll
        for (int ai = 0; ai < 2; ++ai)
#pragma unroll
            for (int m = 0; m < 4; ++m) { const int row = row0 + ai * HALF + m * 16; const f32x4* sp = (const f32x4*)(SSQP + (size_t)row * 20 + 12);
                const f32x4 a = sp[0], b = sp[1]; const float s = ((a[0] + a[1]) + (a[2] + a[3])) + ((b[0] + b[1]) + (b[2] + b[3]));
                const float rs = rsqrtf(s * (1.f / 512.f) + 1e-6f);
                int bb, key; if (row < 8192) { bb = row >> 12; key = row & 4095; } else { bb = (row - 8192) >> 8; key = 4096 + ((row - 8192) & 255); }
#pragma unroll
                for (int bj = 0; bj < 2; ++bj) { const f32x4 v0 = acc[ai][bj][m][0] * rs, v1 = acc[ai][bj][m][1] * rs;
                    u32x4 w; w.x = cvt_pk_bf16(v0[0], v0[1]); w.y = cvt_pk_bf16(v0[2], v0[3]); w.z = cvt_pk_bf16(v1[0], v1[1]); w.w = cvt_pk_bf16(v1[2], v1[3]);
                    if (bj == 0) *(u32x4*)(KN + (size_t)row * 1024 + h * 128 + cw) = w;
                    else *(u32x4*)(V + ((size_t)(bb * 8 + h) * 4352 + key) * 128 + cw) = w; } }
    }
};

struct OrdOne {
    int pm, pn;
    __device__ bool next(int i, Unit& u) const { if (i) return false; u.pm = pm; u.pn = pn; return true; }
    __device__ __forceinline__ void a_ready(const Unit&) const {}
    __device__ __forceinline__ void done(const Unit&) const {}
};
struct EpiFold { static constexpr bool PERM = true, AFTER_DRAIN = false;
    bf16_t* W; int g, pad;
    __device__ __forceinline__ void operator()(const f32x4 (&acc)[2][2][4][2], const Unit& u, int wr, int wc, int fr, int fq) const {
        const int r0 = wr * 64 + fr, col0 = u.pn * BM + wc * 32 + 8 * fq;
#pragma unroll
        for (int ai = 0; ai < 2; ++ai)
#pragma unroll
            for (int m = 0; m < 4; ++m) { const int kc = r0 + ai * HALF + m * 16; bf16_t* rowp = W + (size_t)(u.pm * 1024 + g * 256 + kc) * 2048 + col0;
#pragma unroll
                for (int bj = 0; bj < 2; ++bj) { const f32x4 v0 = acc[ai][bj][m][0], v1 = acc[ai][bj][m][1];
                    u32x4 w; w.x = cvt_pk_bf16(v0[0], v0[1]); w.y = cvt_pk_bf16(v0[2], v0[3]); w.z = cvt_pk_bf16(v1[0], v1[1]); w.w = cvt_pk_bf16(v1[2], v1[3]);
                    *(u32x4*)(rowp + bj * HALF) = w; } }
    }
};
struct EpiOut { static constexpr bool PERM = false, AFTER_DRAIN = false;
    float* out; const float* x; const float* mod;
    __device__ __forceinline__ void operator()(const f32x4 (&acc)[2][2][4][2], const Unit& u, int wr, int wc, int fr, int fq) const {
        const int row0 = u.pm * BM + wr * 64 + fr, col0 = u.pn * BM + wc * 32 + 4 * fq; const float* gt = mod + (u.pm >> 4) * 12288 + 4096;
        f32x4 gv[2][2];
#pragma unroll
        for (int bj = 0; bj < 2; ++bj)
#pragma unroll
            for (int n = 0; n < 2; ++n) gv[bj][n] = *(const f32x4*)(gt + col0 + bj * HALF + n * 16);
        f32x4 xa[4], xb[4];
#define EPO_LOAD(X, g_) do { const size_t off_ = (size_t)(row0 + ((g_) >> 2) * HALF + ((g_) & 3) * 16) * 2048 + col0; \
            _Pragma("unroll") for (int q_ = 0; q_ < 4; ++q_) X[q_] = *(const f32x4*)(x + off_ + (q_ >> 1) * HALF + (q_ & 1) * 16); } while (0)
#define EPO_STORE(X, g_) do { const size_t off_ = (size_t)(row0 + ((g_) >> 2) * HALF + ((g_) & 3) * 16) * 2048 + col0; \
            _Pragma("unroll") for (int q_ = 0; q_ < 4; ++q_) *(f32x4*)(out + off_ + (q_ >> 1) * HALF + (q_ & 1) * 16) = X[q_] + gv[q_ >> 1][q_ & 1] * acc[(g_) >> 2][q_ >> 1][(g_) & 3][q_ & 1]; } while (0)
        EPO_LOAD(xa, 0);
#pragma unroll
        for (int g = 0; g < 8; g += 2) {
            EPO_LOAD(xb, g + 1); __builtin_amdgcn_sched_barrier(0);
            EPO_STORE(xa, g); __builtin_amdgcn_sched_barrier(0);
            if (g + 2 < 8) { EPO_LOAD(xa, g + 2); } __builtin_amdgcn_sched_barrier(0);
            EPO_STORE(xb, g + 1); __builtin_amdgcn_sched_barrier(0);
        }
#undef EPO_LOAD
#undef EPO_STORE
    }
};
template <class Epi, class Sched, bool STAMP = false>
__device__ __forceinline__ void gemm_phase(PG8_LAS unsigned char* lds, const Gemm g, const Sched& S, const Epi& E, unsigned long long* stamps) {
    const int tid = threadIdx.x, wid = __builtin_amdgcn_readfirstlane(tid >> 6), lane = tid & 63, wr = wid >> 2, wc = wid & 3, fr = lane & 15, fq = lane >> 4;
    const int K = g.K, nt = K / BK;
    int ts_lo = 0, ts_hi = 0, nts = 0; const unsigned long long rt_entry = STAMP ? (unsigned long long)wall_clock64() : 0ull;
#define PG8_STAMP() do { if (STAMP && wid == 0 && nts < 64) { const unsigned long long _c = (unsigned long long)clock64(); \
        ts_lo = (lane == nts) ? (int)(unsigned)_c : ts_lo; ts_hi = (lane == nts) ? (int)(unsigned)(_c >> 32) : ts_hi; ++nts; } } while (0)
    PG8_STAMP();
    unsigned voffA[2], voffB[2];
#pragma unroll
    for (int i = 0; i < 2; ++i) { int R, C; stage_rc(tid * 16 + i * 8192, R, C); const int Rb = Epi::PERM ? ((R & ~31) + perm32(R & 31)) : R;
        voffA[i] = (unsigned)(R * g.lda + C) * 2u; voffB[i] = (unsigned)(Rb * g.ldb + C) * 2u; }
    const size_t kstep = (size_t)(BK * 2);
    const size_t hstepA = (size_t)HALF * g.lda * 2, hstepB = (size_t)HALF * g.ldb * 2;
    const size_t tstepA = 2 * hstepA, tstepB = 2 * hstepB;
    const unsigned ldsw = (unsigned)wid * 1024u;
    const int aoff = lds_byte(wr * 64 + fr, fq * 8), boff = lds_byte(wc * 32 + fr, fq * 8);
#define PG8_SA(b, h) (((b) * 2 + (h)) * HTB)
#define PG8_SB(b, h) ((4 + (b) * 2 + (h)) * HTB)
#define PG8_STAGE(bufoff, gbase, voff) do { _Pragma("unroll") for (int _i = 0; _i < 2; ++_i) \
        __builtin_amdgcn_global_load_lds((const unsigned*)((const char*)(gbase) + (voff)[_i]), (PG8_LAS unsigned*)(lds + (bufoff) + ldsw + _i * 8192), 16, 0, 0); } while (0)
#define PG8_LDA(dst, b, h) do { _Pragma("unroll") for (int m = 0; m < 4; ++m) _Pragma("unroll") for (int k = 0; k < 2; ++k) dst[m][k] = *(const PG8_LAS bf16x8*)(lds + PG8_SA(b, h) + aoff + m * 2048 + k * 1024); } while (0)
#define PG8_LDB(dst, b, h) do { _Pragma("unroll") for (int n = 0; n < 2; ++n) _Pragma("unroll") for (int k = 0; k < 2; ++k) dst[n][k] = *(const PG8_LAS bf16x8*)(lds + PG8_SB(b, h) + boff + n * 2048 + k * 1024); } while (0)
#define PG8_MMA(ai, bj, At, Bt) do { __builtin_amdgcn_s_setprio(1); _Pragma("unroll") for (int m = 0; m < 4; ++m) _Pragma("unroll") for (int n = 0; n < 2; ++n) _Pragma("unroll") for (int k = 0; k < 2; ++k) \
        acc[ai][bj][m][n] = __builtin_amdgcn_mfma_f32_16x16x32_bf16(Bt[n][k], At[m][k], acc[ai][bj][m][n], 0, 0, 0); __builtin_amdgcn_s_setprio(0); } while (0)
#define PG8_WAIT_V(n) asm volatile("s_waitcnt vmcnt(" #n ")" ::: "memory")
#define PG8_WAIT_L(n) asm volatile("s_waitcnt lgkmcnt(" #n ")" ::: "memory")
#define PG8_BAR __builtin_amdgcn_s_barrier()
#define PG8_SCHED __builtin_amdgcn_sched_barrier(0)
    Unit cur, nxt; int ui = 0;
    if (!S.next(0, cur)) return;
    f32x4 acc[2][2][4][2];
#pragma unroll
    for (int a = 0; a < 2; ++a)
#pragma unroll
        for (int b = 0; b < 2; ++b)
#pragma unroll
            for (int m = 0; m < 4; ++m)
#pragma unroll
                for (int n = 0; n < 2; ++n) acc[a][b][m][n] = (f32x4){0.f, 0.f, 0.f, 0.f};
    bf16x8 At[4][2], B0[2][2], B1[2][2];
    const char* cA = (const char*)g.A + (size_t)cur.pm * tstepA; const char* cB = (const char*)g.Bt + (size_t)cur.pn * tstepB;
    S.a_ready(cur);
    PG8_STAGE(PG8_SB(0, 0), cB, voffB); PG8_STAGE(PG8_SA(0, 0), cA, voffA); PG8_STAGE(PG8_SB(0, 1), cB + hstepB, voffB); PG8_STAGE(PG8_SA(0, 1), cA + hstepA, voffA);
    if (wr == 1) PG8_BAR;
    PG8_WAIT_V(4); PG8_BAR;
    PG8_STAGE(PG8_SB(1, 0), cB + kstep, voffB); PG8_STAGE(PG8_SA(1, 0), cA + kstep, voffA); PG8_STAGE(PG8_SB(1, 1), cB + hstepB + kstep, voffB);
    PG8_WAIT_V(6); PG8_BAR;
    PG8_STAMP();
    for (;;) {
        const bool has_next = S.next(ui + 1, nxt);
        const char* nA = has_next ? (const char*)g.A + (size_t)nxt.pm * tstepA : cA; const char* nB = has_next ? (const char*)g.Bt + (size_t)nxt.pn * tstepB : cB;
        for (int t = 0; t < nt; t += 2) {
            const bool last = (t == nt - 2);
            const char* a1 = cA + (size_t)(t + 1) * kstep;
            const char* a2 = last ? nA : cA + (size_t)(t + 2) * kstep; const char* b2 = last ? nB : cB + (size_t)(t + 2) * kstep;
            const char* a3 = a2 + kstep; const char* b3 = b2 + kstep;
            if (last && has_next) S.a_ready(nxt);
            PG8_LDB(B0, 0, 0); PG8_SCHED; PG8_LDA(At, 0, 0); PG8_STAGE(PG8_SA(1, 1), a1 + hstepA, voffA);
            PG8_WAIT_L(8); PG8_BAR; PG8_WAIT_L(0); PG8_MMA(0, 0, At, B0); PG8_BAR; PG8_SCHED;
            PG8_LDB(B1, 0, 1); PG8_STAGE(PG8_SB(0, 0), b2, voffB);
            PG8_BAR; PG8_WAIT_L(0); PG8_MMA(0, 1, At, B1); PG8_BAR;
            PG8_LDA(At, 0, 1); PG8_STAGE(PG8_SA(0, 0), a2, voffA);
            PG8_BAR; PG8_WAIT_L(0); PG8_MMA(1, 0, At, B0); PG8_BAR; PG8_SCHED;
            PG8_STAGE(PG8_SB(0, 1), b2 + hstepB, voffB);
            PG8_WAIT_V(6); PG8_BAR; PG8_MMA(1, 1, At, B1); PG8_BAR;
            PG8_LDB(B0, 1, 0); PG8_SCHED; PG8_LDA(At, 1, 0); PG8_STAGE(PG8_SA(0, 1), a2 + hstepA, voffA);
            PG8_WAIT_L(8); PG8_BAR; PG8_WAIT_L(0); PG8_MMA(0, 0, At, B0); PG8_BAR; PG8_SCHED;
            PG8_LDB(B1, 1, 1); PG8_STAGE(PG8_SB(1, 0), b3, voffB);
            PG8_BAR; PG8_WAIT_L(0); PG8_MMA(0, 1, At, B1); PG8_BAR;
            PG8_LDA(At, 1, 1); PG8_STAGE(PG8_SA(1, 0), a3, voffA);
            PG8_BAR; PG8_WAIT_L(0); PG8_MMA(1, 0, At, B0); PG8_BAR; PG8_SCHED;
            PG8_STAGE(PG8_SB(1, 1), b3 + hstepB, voffB);
            PG8_WAIT_V(6); PG8_BAR; PG8_MMA(1, 1, At, B1); PG8_BAR;
        }
        PG8_STAMP();
        if constexpr (!Epi::AFTER_DRAIN) { E(acc, cur, wr, wc, fr, fq); S.done(cur); }
        PG8_STAMP();
        if (!has_next) break;
#pragma unroll
        for (int a = 0; a < 2; ++a)
#pragma unroll
            for (int b = 0; b < 2; ++b)
#pragma unroll
                for (int m = 0; m < 4; ++m)
#pragma unroll
                    for (int n = 0; n < 2; ++n) acc[a][b][m][n] = (f32x4){0.f, 0.f, 0.f, 0.f};
        cur = nxt; cA = nA; cB = nB; ++ui;
    }
    PG8_WAIT_V(0);
    if (wr == 0) PG8_BAR;
    PG8_BAR;
    if constexpr (Epi::AFTER_DRAIN) { E.fused(acc, cur, wr, wc, fr, fq, lds, wid, lane); S.done(cur); }
    PG8_STAMP();
    if (STAMP && wid == 0) { stamps[lane] = lane < nts ? (((unsigned long long)(unsigned)ts_hi << 32) | (unsigned)ts_lo) : 0ull;
        if (lane == 62) stamps[62] = rt_entry; if (lane == 63) stamps[63] = (unsigned long long)wall_clock64(); }
#undef PG8_STAMP
#undef PG8_SA
#undef PG8_SB
#undef PG8_STAGE
#undef PG8_LDA
#undef PG8_LDB
#undef PG8_MMA
#undef PG8_WAIT_V
#undef PG8_WAIT_L
#undef PG8_BAR
#undef PG8_SCHED
}
}

namespace att {
using u32x4s = __attribute__((ext_vector_type(4))) unsigned;
using bf16x8 = __attribute__((ext_vector_type(8))) short;
using s16x4  = __attribute__((ext_vector_type(4))) short;
using f32x16 = __attribute__((ext_vector_type(16))) float;
using u32x4  = __attribute__((ext_vector_type(4))) unsigned;
constexpr int DQ = 192, DV = 128, NW = 8, QBLK = 32, KVBLK = 64, KROW = 400  ;
constexpr float SCALE = 0.07216878364870323f;
constexpr float THR = 8.f;
constexpr int SHM_V = KVBLK * DV * 2, SHM_K = KVBLK * KROW, SHM_QX = 2 * SHM_V + 2 * SHM_K + NW * 64 * 4, SHM_ATTN = SHM_QX + NW * 4096;
#define ATT_SBAR() __builtin_amdgcn_sched_barrier(0)
__device__ __forceinline__ int crow(int r, int hi) { return (r & 3) + 8 * (r >> 2) + 4 * hi; }
__device__ __forceinline__ unsigned cvtpk(float lo, float hi) { unsigned r; asm volatile("v_cvt_pk_bf16_f32 %0, %1, %2" : "=v"(r) : "v"(lo), "v"(hi)); return r; }
__device__ __forceinline__ void partialSM(f32x16& p0, f32x16& p1, float& m_reg, float& mn, float& alpha) {
  constexpr float C = SCALE * 1.4426950408889634f;
  float pmax = p0[0];
#pragma unroll
  for (int r = 1; r < 16; ++r) pmax = fmaxf(pmax, p0[r]);
#pragma unroll
  for (int r = 0; r < 16; ++r) pmax = fmaxf(pmax, p1[r]);
  { auto rr = __builtin_amdgcn_permlane32_swap(__float_as_uint(pmax), __float_as_uint(pmax), false, false);
    pmax = fmaxf(__uint_as_float(rr[0]), __uint_as_float(rr[1])); }
  if (__builtin_expect(__all(pmax - m_reg <= THR / SCALE), 1)) { mn = m_reg; alpha = 1.f; }
  else { mn = fmaxf(m_reg, pmax); alpha = __builtin_amdgcn_exp2f((m_reg - mn) * C); m_reg = mn; }
  const float mnC = -mn * C;
#pragma unroll
  for (int r = 0; r < 16; ++r) p0[r] = fmaf(p0[r], C, mnC);
#pragma unroll
  for (int r = 0; r < 16; ++r) p1[r] = fmaf(p1[r], C, mnC);
#pragma unroll
  for (int r = 0; r < 16; ++r) p0[r] = __builtin_amdgcn_exp2f(p0[r]);
}
__device__ __forceinline__ void finishSM(f32x16& p0, f32x16& p1, float alpha, float& l_reg, bf16x8& pa0, bf16x8& pa1, bf16x8& pa2, bf16x8& pa3) {
#pragma unroll
  for (int r = 0; r < 16; ++r) p1[r] = __builtin_amdgcn_exp2f(p1[r]);
  float ps = 0;
#pragma unroll
  for (int r = 0; r < 16; ++r) ps += p0[r];
#pragma unroll
  for (int r = 0; r < 16; ++r) ps += p1[r];
  { auto rr = __builtin_amdgcn_permlane32_swap(__float_as_uint(ps), __float_as_uint(ps), false, false);
    ps = __uint_as_float(rr[0]) + __uint_as_float(rr[1]); }
  l_reg = l_reg * alpha + ps;
#define ATT_PK4(P, BASE, OUT) do { unsigned a0 = cvtpk(P[BASE + 0], P[BASE + 1]), a1 = cvtpk(P[BASE + 2], P[BASE + 3]);   \
    unsigned b0 = cvtpk(P[BASE + 4], P[BASE + 5]), b1 = cvtpk(P[BASE + 6], P[BASE + 7]);                              \
    auto r0 = __builtin_amdgcn_permlane32_swap(a0, b0, false, false); auto r1 = __builtin_amdgcn_permlane32_swap(a1, b1, false, false); \
    u32x4 w = {r0[0], r1[0], r0[1], r1[1]}; OUT = *reinterpret_cast<bf16x8*>(&w); } while (0)
  ATT_PK4(p0, 0, pa0); ATT_PK4(p0, 8, pa1); ATT_PK4(p1, 0, pa2); ATT_PK4(p1, 8, pa3);
#undef ATT_PK4
}
__device__ __forceinline__ void qkt(f32x16& p0, f32x16& p1, const char* Ks, const bf16x8* qr, const char* qx, int r32, int hi) {
  p0 = f32x16{}; p1 = f32x16{};
#pragma unroll
  for (int d0 = 0; d0 < 12; ++d0) { const int cb = (d0 * 16 + hi * 8) * 2;
    const bf16x8 b0 = *reinterpret_cast<const bf16x8*>(Ks + r32 * KROW + cb);
    const bf16x8 b1 = *reinterpret_cast<const bf16x8*>(Ks + (32 + r32) * KROW + cb);
    const bf16x8 q = d0 < 8 ? qr[d0] : *reinterpret_cast<const bf16x8*>(qx + (d0 - 8) * 1024);
    p0 = __builtin_amdgcn_mfma_f32_32x32x16_bf16(b0, q, p0, 0, 0, 0);
    p1 = __builtin_amdgcn_mfma_f32_32x32x16_bf16(b1, q, p1, 0, 0, 0); }
}
__device__ __forceinline__ int v_st(int k, int c) { const int kk = (k & ~0xC) | ((k & 4) << 1) | ((k & 8) >> 1); return ((kk >> 3) * 4 + (c >> 5)) * 512 + ((kk & 7) * 32 + (c & 31)) * 2; }
__device__ __forceinline__ int v_rd_base(int lane) { return ((lane & 3) << 3) | (((lane >> 2) & 3) << 6) | (((lane >> 4) & 1) << 5) | (((lane >> 5) & 1) << 8); }
constexpr int v_rd_off(int d0, int ks, int half) { return d0 * 512 + ks * 4096 + half * 2048; }
template <int OFF> __device__ __forceinline__ s16x4 tr_read(int vb) {
  s16x4 r; asm volatile("ds_read_b64_tr_b16 %0, %1 offset:%2" : "=&v"(r) : "v"(vb), "i"(OFF) : "memory"); return r;
}
template <int D0> __device__ __forceinline__ void pv_one(f32x16& od, int vb, bf16x8 pa0, bf16x8 pa1, bf16x8 pa2, bf16x8 pa3) {
  const s16x4 l0 = tr_read<v_rd_off(D0, 0, 0)>(vb), h0 = tr_read<v_rd_off(D0, 0, 1)>(vb), l1 = tr_read<v_rd_off(D0, 1, 0)>(vb), h1 = tr_read<v_rd_off(D0, 1, 1)>(vb);
  const s16x4 l2 = tr_read<v_rd_off(D0, 2, 0)>(vb), h2 = tr_read<v_rd_off(D0, 2, 1)>(vb), l3 = tr_read<v_rd_off(D0, 3, 0)>(vb), h3 = tr_read<v_rd_off(D0, 3, 1)>(vb);
  asm volatile("s_waitcnt lgkmcnt(0)" ::: "memory"); ATT_SBAR();
#define ATT_PK(L, H) (bf16x8){L[0], L[1], L[2], L[3], H[0], H[1], H[2], H[3]}
  od = __builtin_amdgcn_mfma_f32_32x32x16_bf16(pa0, ATT_PK(l0, h0), od, 0, 0, 0);
  od = __builtin_amdgcn_mfma_f32_32x32x16_bf16(pa1, ATT_PK(l1, h1), od, 0, 0, 0);
  od = __builtin_amdgcn_mfma_f32_32x32x16_bf16(pa2, ATT_PK(l2, h2), od, 0, 0, 0);
  od = __builtin_amdgcn_mfma_f32_32x32x16_bf16(pa3, ATT_PK(l3, h3), od, 0, 0, 0);
#undef ATT_PK
}
__device__ __forceinline__ void pv_d0(f32x16* o, int vb, bf16x8 pa0, bf16x8 pa1, bf16x8 pa2, bf16x8 pa3) {
  pv_one<0>(o[0], vb, pa0, pa1, pa2, pa3); pv_one<1>(o[1], vb, pa0, pa1, pa2, pa3); pv_one<2>(o[2], vb, pa0, pa1, pa2, pa3); pv_one<3>(o[3], vb, pa0, pa1, pa2, pa3);
}
struct SideJob { const float* wg; const float* wu; unsigned char* w8; int s0, n; };
__device__ __forceinline__ void attn_body(const bf16_t* __restrict__ Qb, const bf16_t* __restrict__ Kh, const bf16_t* __restrict__ Vh, bf16_t* __restrict__ Ob, int ldo, int seq, char* lds, const SideJob sj) {
  const int tid = threadIdx.x, wid = tid >> 6, lane = tid & 63, r32 = lane & 31, hi = lane >> 5;
  char* V_lds = lds; char* K_lds = lds + 2 * SHM_V;
  float* ws = (float*)(lds + 2 * SHM_V + 2 * SHM_K) + wid * 64; float* li_l = ws; float* al_l = ws + 32;
  float m_reg = -1e30f, l_reg = 0; f32x16 o[4] = {}; bf16x8 qr[8];
  const bf16_t* Qw = Qb + (long)(wid * QBLK + r32) * DQ + hi * 8;
#pragma unroll
  for (int d0 = 0; d0 < 8; ++d0) qr[d0] = *reinterpret_cast<const bf16x8*>(Qw + d0 * 16);
  char* qx = lds + SHM_QX + wid * 4096 + lane * 16;
#pragma unroll
  for (int d0 = 8; d0 < 12; ++d0) *reinterpret_cast<bf16x8*>(qx + (d0 - 8) * 1024) = *reinterpret_cast<const bf16x8*>(Qw + d0 * 16);
  const int sr = tid >> 4, sc = (tid & 15) * 8, vst0 = v_st(sr, sc), vst1 = v_st(32 + sr, sc);
  const int kr = tid >> 3, kc = (tid & 7) * 8;
  const int kst = kr * KROW + kc * 2;
  const int vb0 = (int)(uintptr_t)V_lds + v_rd_base(lane);
  bf16x8 vs0, vs1, ks0, ks1, ks2;
#define ATT_SLOAD(k0) do { vs0 = *reinterpret_cast<const bf16x8*>(&Vh[(long)((k0) + sr) * DV + sc]); vs1 = *reinterpret_cast<const bf16x8*>(&Vh[(long)((k0) + 32 + sr) * DV + sc]); \
    const bf16_t* kp_ = &Kh[(long)((k0) + kr) * DQ + kc]; ks0 = *reinterpret_cast<const bf16x8*>(kp_); ks1 = *reinterpret_cast<const bf16x8*>(kp_ + 64); ks2 = *reinterpret_cast<const bf16x8*>(kp_ + 128); } while (0)
#define ATT_SWRITE(b) do { *(bf16x8*)(V_lds + (b) * SHM_V + vst0) = vs0; *(bf16x8*)(V_lds + (b) * SHM_V + vst1) = vs1; \
    *(bf16x8*)(K_lds + (b) * SHM_K + kst) = ks0; *(bf16x8*)(K_lds + (b) * SHM_K + kst + 128) = ks1; *(bf16x8*)(K_lds + (b) * SHM_K + kst + 256) = ks2; } while (0)
#define ATT_SWAIT() asm volatile("s_waitcnt vmcnt(0)" ::: "memory")
#define ATT_RESC(a) do { if (__any((a) < 1.f)) { if (hi == 0) al_l[r32] = (a); asm volatile("s_waitcnt lgkmcnt(0)" ::: "memory"); \
    _Pragma("unroll") for (int d = 0; d < 4; ++d) _Pragma("unroll") for (int r = 0; r < 16; ++r) o[d][r] *= al_l[crow(r, hi)]; } } while (0)
  f32x16 p0, p1; float mn, al; bf16x8 pa0, pa1, pa2, pa3; const int NT = seq / KVBLK;
  ATT_SLOAD(0); ATT_SWAIT(); ATT_SWRITE(0); __syncthreads();
  ATT_SLOAD(KVBLK);
  u32x4 sw[4] = {}; const int s_half = __builtin_amdgcn_readfirstlane(tid >> 8), s_ng = tid & 15, s_kq = (tid & 255) >> 4;
#define ATT_SIDE_LOAD(jj_) do { const int s_ = sj.s0 + (jj_); if (s_ < sj.n) { const int uid_ = s_ >> 5, t_ = s_ & 31, e_ = uid_ / 12, jc_ = uid_ - e_ * 12; \
      const float* wp_ = (s_half ? sj.wu : sj.wg) + (size_t)e_ * (2048 * 768) + (size_t)(64 * t_ + 4 * s_kq) * 768 + jc_ * 64 + 4 * s_ng; \
      _Pragma("unroll") for (int q_ = 0; q_ < 4; ++q_) sw[q_] = *(const u32x4*)(wp_ + q_ * 768); } } while (0)
#define ATT_SIDE_STORE(jj_) do { const int s_ = sj.s0 + (jj_); if (s_ < sj.n) { u32x4 w_; \
      _Pragma("unroll") for (int i_ = 0; i_ < 4; ++i_) { int p_ = __builtin_amdgcn_cvt_pk_fp8_f32(__uint_as_float(sw[0][i_]), __uint_as_float(sw[1][i_]), 0, false); \
          p_ = __builtin_amdgcn_cvt_pk_fp8_f32(__uint_as_float(sw[2][i_]), __uint_as_float(sw[3][i_]), p_, true); w_[i_] = (unsigned)p_; } \
      *(u32x4*)(sj.w8 + ((size_t)s_ * 512 + tid) * 16) = w_; } } while (0)
  for (int j = 0; j < NT; ++j) {
    const int buf = j & 1;
    ATT_SBAR(); qkt(p0, p1, K_lds + buf * SHM_K, qr, qx, r32, hi);
    partialSM(p0, p1, m_reg, mn, al);
    ATT_RESC(al);
    finishSM(p0, p1, al, l_reg, pa0, pa1, pa2, pa3); ATT_SBAR();
    ATT_SWAIT();
    if (j + 1 < NT) { ATT_SWRITE(buf ^ 1); }
    if (j > 0) ATT_SIDE_STORE(j - 1);
    if (j + 2 < NT) ATT_SLOAD((j + 2) * KVBLK);
    ATT_SIDE_LOAD(j);
    ATT_SBAR();
    pv_d0(o, vb0 + buf * SHM_V, pa0, pa1, pa2, pa3);
    __syncthreads();
  }
  ATT_SWAIT(); ATT_SIDE_STORE(NT - 1);
#undef ATT_SIDE_LOAD
#undef ATT_SIDE_STORE
  if (hi == 0) li_l[r32] = l_reg; asm volatile("s_waitcnt lgkmcnt(0)" ::: "memory");
  float rli[16];
#pragma unroll
  for (int r = 0; r < 16; ++r) rli[r] = __builtin_amdgcn_rcpf(li_l[crow(r, hi)]);
  bf16_t* Ow = Ob + (long)(wid * QBLK) * ldo;
#pragma unroll
  for (int r = 0; r < 16; ++r) { const int orow = crow(r, hi);
#pragma unroll
    for (int d0 = 0; d0 < 4; ++d0) Ow[(long)orow * ldo + d0 * 32 + r32] = (bf16_t)(cvtpk(o[d0][r] * rli[r], 0.f) & 0xffffu); }
  __syncthreads();
#undef ATT_SLOAD
#undef ATT_SWRITE
#undef ATT_SWAIT
#undef ATT_RESC
}
}

namespace moe {
using bf16x8 = __attribute__((ext_vector_type(8))) short;
using f32x4 = __attribute__((ext_vector_type(4))) float;
using u32x4 = __attribute__((ext_vector_type(4))) unsigned;
using i32x8 = __attribute__((ext_vector_type(8))) int;
constexpr int TM = 384, A_BYTES = TM * 128, B_BYTES = 128 * 128;
#define MOE_AUX 0
constexpr int LDS_A = 0, LDS_B = 2 * A_BYTES, LDS_ROW = LDS_B + 2 * B_BYTES, LDS_BASE = LDS_ROW + TM * 4, LDS_BYTES = LDS_BASE + 64 * 4;
__device__ __forceinline__ unsigned cvtpk(float lo, float hi) { unsigned r; asm volatile("v_cvt_pk_bf16_f32 %0, %1, %2" : "=v"(r) : "v"(lo), "v"(hi)); return r; }

template <int MODE, int NM, int PROBE, bool PRE, bool SAVE = false>
__device__ __forceinline__ void moe_pass(const __amdgpu_buffer_rsrc_t rsA, const __amdgpu_buffer_rsrc_t rsB, const __amdgpu_buffer_rsrc_t rsS, const float* __restrict__ slw_e, void* __restrict__ Outv,
                                         int rows, int orow0, int ncol0, int rot, int wid, int lane, unsigned boff, unsigned soff, int bwb, int brd, const int* rowidx, char* lds) {
    constexpr int K = MODE == 0 ? 2048 : 768, NK = K / 128, LDW = MODE == 0 ? 768 : 2048, APITCH = MODE == 0 ? 2176 : 768, BB = 128 * 64;
    const int fr = lane & 15, fq = lane >> 4;
    unsigned aoff[NM];
#pragma unroll
    for (int mi = 0; mi < NM; ++mi) aoff[mi] = (unsigned)rowidx[(wid + 8 * mi) * 16 + fr] * (unsigned)APITCH + (unsigned)fq * 16u;
    f32x4 accg[NM][4], accu[NM][4];
#pragma unroll
    for (int mi = 0; mi < NM; ++mi)
#pragma unroll
        for (int nt = 0; nt < 4; ++nt) { accg[mi][nt] = (f32x4){0.f, 0.f, 0.f, 0.f}; accu[mi][nt] = (f32x4){0.f, 0.f, 0.f, 0.f}; }
    u32x4 aA[NM][2] = {}, aB[NM][2] = {};
    const int rotk = rot % NK;
#define KS(t_) ((((t_) + rotk) % NK) * 128)
#define MOE_LOADA(AF, k0) do { if (!(PROBE & 1)) { _Pragma("unroll") for (int mi = 0; mi < NM; ++mi) { AF[mi][0] = __builtin_amdgcn_raw_buffer_load_b128(rsA, aoff[mi], (k0), 0); AF[mi][1] = __builtin_amdgcn_raw_buffer_load_b128(rsA, aoff[mi], (k0) + 64, 0); } } } while (0)
#define MOE_LOADB(RB, k0) do { if (!(PROBE & 2)) { _Pragma("unroll") for (int jj = 0; jj < 4; ++jj) RB[jj] = __builtin_amdgcn_raw_buffer_load_b128(rsB, boff, ((k0) + jj) * (LDW * 4), 0); } } while (0)
#define MOE_WRITEB(RB, img, k0) do { u32x4 pk_; _Pragma("unroll") for (int i = 0; i < 4; ++i) { int p_ = __builtin_amdgcn_cvt_pk_fp8_f32(__uint_as_float(RB[0][i]), __uint_as_float(RB[1][i]), 0, false); \
        p_ = __builtin_amdgcn_cvt_pk_fp8_f32(__uint_as_float(RB[2][i]), __uint_as_float(RB[3][i]), p_, true); *(int*)(lds + (img) * BB + bwb + i * 64) = p_; pk_[i] = (unsigned)p_; } \
        if (SAVE) __builtin_amdgcn_raw_buffer_store_b128(pk_, rsS, soff, ((k0) >> 6) * 8192, 0); } while (0)
#define MOE_LOADP(RP, k0) do { if (!(PROBE & 2)) { RP[0] = __builtin_amdgcn_raw_buffer_load_b128(rsB, boff, ((k0) >> 6) * 8192, 0); RP[1] = __builtin_amdgcn_raw_buffer_load_b128(rsB, boff, ((k0) >> 6) * 8192 + 8192, 0); } } while (0)
#define MOE_WRITEP(RP, pr) do { _Pragma("unroll") for (int h_ = 0; h_ < 2; ++h_) { _Pragma("unroll") for (int i = 0; i < 4; ++i) *(int*)(lds + (2 * (pr) + h_) * BB + bwb + i * 64) = (int)RP[h_][i]; } } while (0)
#define MOE_CAT(lo_, hi_) ((i32x8){(int)(lo_)[0], (int)(lo_)[1], (int)(lo_)[2], (int)(lo_)[3], (int)(hi_)[0], (int)(hi_)[1], (int)(hi_)[2], (int)(hi_)[3]})
#define MOE_COMPUTE(pr, AF, ACC, hs) do { if (PROBE & 4) break; u32x4 bl[4], bh[4]; \
        _Pragma("unroll") for (int nt = 0; nt < 4; ++nt) { bl[nt] = *(const u32x4*)(lds + (2 * (pr)) * BB + brd + (4 * (hs) + nt) * 1024); bh[nt] = *(const u32x4*)(lds + (2 * (pr) + 1) * BB + brd + (4 * (hs) + nt) * 1024); } \
        _Pragma("unroll") for (int nt = 0; nt < 4; ++nt) { const i32x8 bw_ = MOE_CAT(bl[nt], bh[nt]); \
            _Pragma("unroll") for (int mi = 0; mi < NM; ++mi) ACC[mi][nt] = __builtin_amdgcn_mfma_scale_f32_16x16x128_f8f6f4(bw_, MOE_CAT(AF[mi][0], AF[mi][1]), ACC[mi][nt], 0, 0, 0, 0, 0, 0); } } while (0)
    if constexpr (!PRE && NM == 2 && NK % 4 == 0) {
        u32x4 rb0[4] = {}, rb1[4] = {}, aC[NM][2] = {}, aD[NM][2] = {};
        MOE_LOADA(aA, KS(0)); MOE_LOADB(rb0, KS(0)); MOE_LOADB(rb1, KS(0) + 64); MOE_LOADA(aB, KS(1)); MOE_LOADA(aC, KS(2));
        MOE_WRITEB(rb0, 0, KS(0)); MOE_LOADB(rb0, KS(1)); MOE_WRITEB(rb1, 1, KS(0) + 64); MOE_LOADB(rb1, KS(1) + 64);
        __syncthreads();
#define MOE_STEP4(pr, AN, kn, AC, t1, t2) do { MOE_LOADA(AN, KS(kn)); \
            MOE_COMPUTE(pr, AC, accg, 0); MOE_WRITEB(rb0, 2 * (1 - (pr)), KS(t1)); MOE_LOADB(rb0, KS(t2)); \
            MOE_COMPUTE(pr, AC, accu, 1); MOE_WRITEB(rb1, 2 * (1 - (pr)) + 1, KS(t1) + 64); MOE_LOADB(rb1, KS(t2) + 64); __syncthreads(); } while (0)
        for (int t = 0; t < NK; t += 4) {
            MOE_STEP4(0, aD, t + 3, aA, t + 1, t + 2);
            MOE_STEP4(1, aA, t + 4, aB, t + 2, t + 3);
            MOE_STEP4(0, aB, t + 5, aC, t + 3, t + 4);
            MOE_STEP4(1, aC, t + 6, aD, t + 4, t + 5);
        }
#undef MOE_STEP4
    } else if constexpr (!PRE) {
        u32x4 rb0[4] = {}, rb1[4] = {};
        MOE_LOADA(aA, KS(0)); MOE_LOADB(rb0, KS(0)); MOE_LOADB(rb1, KS(0) + 64);
        MOE_WRITEB(rb0, 0, KS(0)); MOE_LOADB(rb0, KS(1)); MOE_WRITEB(rb1, 1, KS(0) + 64); MOE_LOADB(rb1, KS(1) + 64);
        __syncthreads();
        for (int t = 0; t < NK; t += 2) {
            MOE_LOADA(aB, KS(t + 1)); if constexpr (MODE == 0) __builtin_amdgcn_sched_barrier(0);
            MOE_COMPUTE(0, aA, accg, 0);
            MOE_WRITEB(rb0, 2, KS(t + 1)); MOE_LOADB(rb0, KS(t + 2));
            MOE_COMPUTE(0, aA, accu, 1);
            MOE_WRITEB(rb1, 3, KS(t + 1) + 64); MOE_LOADB(rb1, KS(t + 2) + 64);
            __syncthreads();
            MOE_LOADA(aA, KS(t + 2)); if constexpr (MODE == 0) __builtin_amdgcn_sched_barrier(0);
            MOE_COMPUTE(1, aB, accg, 0);
            MOE_WRITEB(rb0, 0, KS(t + 2)); MOE_LOADB(rb0, KS(t + 3));
            MOE_COMPUTE(1, aB, accu, 1);
            MOE_WRITEB(rb1, 1, KS(t + 2) + 64); MOE_LOADB(rb1, KS(t + 3) + 64);
            __syncthreads();
        }
    } else if constexpr (NK % 4 != 0) {
        u32x4 rp0[2] = {}, rp1[2] = {};
        MOE_LOADA(aA, KS(0)); MOE_LOADP(rp0, KS(0)); MOE_LOADP(rp1, KS(1));
        MOE_WRITEP(rp0, 0); MOE_LOADP(rp0, KS(2));
        __syncthreads();
        for (int t = 0; t < NK; t += 2) {
            MOE_LOADA(aB, KS(t + 1)); if constexpr (MODE == 0) __builtin_amdgcn_sched_barrier(0);
            MOE_COMPUTE(0, aA, accg, 0); __builtin_amdgcn_sched_barrier(0); MOE_COMPUTE(0, aA, accu, 1);
            MOE_WRITEP(rp1, 1); MOE_LOADP(rp1, KS(t + 3));
            __syncthreads();
            MOE_LOADA(aA, KS(t + 2)); if constexpr (MODE == 0) __builtin_amdgcn_sched_barrier(0);
            MOE_COMPUTE(1, aB, accg, 0); __builtin_amdgcn_sched_barrier(0); MOE_COMPUTE(1, aB, accu, 1);
            MOE_WRITEP(rp0, 0); MOE_LOADP(rp0, KS(t + 4));
            __syncthreads();
        }
    } else if constexpr (NM == 2) {
        u32x4 rp0[2] = {}, rp1[2] = {}, rp2[2] = {}, rp3[2] = {}, aC[NM][2] = {}, aD[NM][2] = {};
        MOE_LOADA(aA, KS(0)); MOE_LOADP(rp0, KS(0)); MOE_LOADA(aB, KS(1)); MOE_LOADP(rp1, KS(1)); MOE_LOADA(aC, KS(2)); MOE_LOADP(rp2, KS(2)); MOE_LOADP(rp3, KS(3));
        MOE_WRITEP(rp0, 0); MOE_LOADP(rp0, KS(4));
        __syncthreads();
        for (int t = 0; t < NK; t += 4) {
            MOE_LOADA(aD, KS(t + 3));
            MOE_COMPUTE(0, aA, accg, 0); __builtin_amdgcn_sched_barrier(0); MOE_COMPUTE(0, aA, accu, 1);
            MOE_WRITEP(rp1, 1); MOE_LOADP(rp1, KS(t + 5));
            __syncthreads();
            MOE_LOADA(aA, KS(t + 4));
            MOE_COMPUTE(1, aB, accg, 0); __builtin_amdgcn_sched_barrier(0); MOE_COMPUTE(1, aB, accu, 1);
            MOE_WRITEP(rp2, 0); MOE_LOADP(rp2, KS(t + 6));
            __syncthreads();
            MOE_LOADA(aB, KS(t + 5));
            MOE_COMPUTE(0, aC, accg, 0); __builtin_amdgcn_sched_barrier(0); MOE_COMPUTE(0, aC, accu, 1);
            MOE_WRITEP(rp3, 1); MOE_LOADP(rp3, KS(t + 7));
            __syncthreads();
            MOE_LOADA(aC, KS(t + 6));
            MOE_COMPUTE(1, aD, accg, 0); __builtin_amdgcn_sched_barrier(0); MOE_COMPUTE(1, aD, accu, 1);
            MOE_WRITEP(rp0, 0); MOE_LOADP(rp0, KS(t + 8));
            __syncthreads();
        }
    } else {
        u32x4 rp0[2] = {}, rp1[2] = {}, rp2[2] = {}, rp3[2] = {};
        MOE_LOADA(aA, KS(0)); MOE_LOADP(rp0, KS(0)); MOE_LOADP(rp1, KS(1)); MOE_LOADP(rp2, KS(2)); MOE_LOADP(rp3, KS(3));
        MOE_WRITEP(rp0, 0); MOE_LOADP(rp0, KS(4));
        __syncthreads();
        for (int t = 0; t < NK; t += 4) {
            MOE_LOADA(aB, KS(t + 1)); if constexpr (MODE == 0) __builtin_amdgcn_sched_barrier(0);
            MOE_COMPUTE(0, aA, accg, 0); __builtin_amdgcn_sched_barrier(0); MOE_COMPUTE(0, aA, accu, 1);
            MOE_WRITEP(rp1, 1); MOE_LOADP(rp1, KS(t + 5));
            __syncthreads();
            MOE_LOADA(aA, KS(t + 2)); if constexpr (MODE == 0) __builtin_amdgcn_sched_barrier(0);
            MOE_COMPUTE(1, aB, accg, 0); __builtin_amdgcn_sched_barrier(0); MOE_COMPUTE(1, aB, accu, 1);
            MOE_WRITEP(rp2, 0); MOE_LOADP(rp2, KS(t + 6));
            __syncthreads();
            MOE_LOADA(aB, KS(t + 3)); if constexpr (MODE == 0) __builtin_amdgcn_sched_barrier(0);
            MOE_COMPUTE(0, aA, accg, 0); __builtin_amdgcn_sched_barrier(0); MOE_COMPUTE(0, aA, accu, 1);
            MOE_WRITEP(rp3, 1); MOE_LOADP(rp3, KS(t + 7));
            __syncthreads();
            MOE_LOADA(aA, KS(t + 4)); if constexpr (MODE == 0) __builtin_amdgcn_sched_barrier(0);
            MOE_COMPUTE(1, aB, accg, 0); __builtin_amdgcn_sched_barrier(0); MOE_COMPUTE(1, aB, accu, 1);
            MOE_WRITEP(rp0, 0); MOE_LOADP(rp0, KS(t + 8));
            __syncthreads();
        }
    }
#undef KS
#undef MOE_LOADA
#undef MOE_LOADB
#undef MOE_WRITEB
#undef MOE_LOADP
#undef MOE_WRITEP
#undef MOE_CAT
#undef MOE_COMPUTE
    asm volatile("s_waitcnt vmcnt(0)" ::: "memory");
    { int laneE = lane; asm volatile("" : "+v"(laneE)); const int frE = laneE & 15, fqE = laneE >> 4;
#pragma unroll
      for (int mi = 0; mi < NM; ++mi) { const int m = (wid + 8 * mi) * 16 + frE;
        if (m < rows && (PROBE == 0 || accg[mi][0][0] == 12345.678f)) {
            if (MODE == 0) { unsigned char* op = (unsigned char*)Outv + (size_t)(orow0 + m) * 768 + ncol0 + 4 * fqE;
#pragma unroll
                for (int nt = 0; nt < 4; ++nt) { f32x4 h;
#pragma unroll
                    for (int r = 0; r < 4; ++r) { const float g = accg[mi][nt][r]; h[r] = g / (1.f + __expf(-g)) * accu[mi][nt][r]; }
                    int p_ = __builtin_amdgcn_cvt_pk_fp8_f32(h[0], h[1], 0, false); p_ = __builtin_amdgcn_cvt_pk_fp8_f32(h[2], h[3], p_, true); *(int*)(op + nt * 16) = p_; } }
            else { bf16_t* op = (bf16_t*)Outv + (size_t)(orow0 + m) * 2048 + ncol0 + 4 * fqE; const float w = slw_e[m];
#pragma unroll
                for (int nt = 0; nt < 4; ++nt) { const f32x4 a = accg[mi][nt] * w, b = accu[mi][nt] * w;
                    uint2 w0_, w1_; w0_.x = cvtpk(a[0], a[1]); w0_.y = cvtpk(a[2], a[3]); w1_.x = cvtpk(b[0], b[1]); w1_.y = cvtpk(b[2], b[3]);
                    *(uint2*)(op + nt * 16) = w0_; *(uint2*)(op + 64 + nt * 16) = w1_; } } } } }
}
template <int MODE, int PROBE = 0>
__device__ __forceinline__ void moe_unit(const unsigned char* __restrict__ Asrc, const int* __restrict__ sltok_e, const float* __restrict__ slw_e,
                                         const float* __restrict__ W0, const float* __restrict__ W1, void* __restrict__ Outv, int cnt, int base, int ncol0, int rot, char* lds, const unsigned char* w8u, unsigned char* sv, unsigned* q, int* nxtl) {
    constexpr int K = MODE == 0 ? 2048 : 768, LDW = MODE == 0 ? 768 : 2048;
    int tid = threadIdx.x; asm volatile("" : "+v"(tid));
    const int wid = __builtin_amdgcn_readfirstlane(tid >> 6), lane = tid & 63, fr = lane & 15, fq = lane >> 4;
    int* rowidx = (int*)(lds + LDS_ROW);
    const int half = tid >> 8, tq = tid & 255, ng = tq & 15, kq = tq >> 4;
    const int halfu = wid >> 2;
    const __amdgpu_buffer_rsrc_t rsB = __builtin_amdgcn_make_buffer_rsrc((void*)(halfu ? W1 : W0), (short)0, K * LDW * 4, 0x00020000);
    const __amdgpu_buffer_rsrc_t rsA = __builtin_amdgcn_make_buffer_rsrc((void*)Asrc, (short)0, MODE == 0 ? 8192 * 2176 : 16384 * 768, 0x00020000);
    const __amdgpu_buffer_rsrc_t rsS = __builtin_amdgcn_make_buffer_rsrc((void*)sv, (short)0, (K / 64) * 8192, 0x00020000);
    const unsigned boff = (unsigned)((4 * kq) * LDW + 4 * ng) * 4u, off8 = (unsigned)tid * 16u;
    const int bwb = LDS_B + (half * 64 + 4 * ng) * 64 + (((kq >> 2) ^ (ng & 3)) << 4) + (kq & 3) * 4;
    const int brd = LDS_B + fr * 64 + ((fq ^ ((fr >> 2) & 3)) << 4);
    int pre = 0;
    if (q != nullptr && tid == 0) pre = (int)__hip_atomic_fetch_add(q, 1u, __ATOMIC_RELAXED, __HIP_MEMORY_SCOPE_AGENT);
    for (int m0 = 0; m0 < cnt; m0 += TM) {
        const int rows = (cnt - m0) < TM ? (cnt - m0) : TM;
        __syncthreads();
        if (tid < TM) { int m = m0 + tid < cnt ? m0 + tid : cnt - 1; if (PROBE & 16) m &= 15; rowidx[tid] = MODE == 0 ? sltok_e[m] : base + m; }
        __syncthreads();
        if (q != nullptr && tid == 0 && m0 == 0) *nxtl = pre;
        if (w8u != nullptr || m0 > 0) {
            const __amdgpu_buffer_rsrc_t rs8 = __builtin_amdgcn_make_buffer_rsrc((void*)(w8u != nullptr ? w8u : sv), (short)0, (K / 64) * 8192, 0x00020000);
            if (rows <= 256) moe_pass<MODE, 2, PROBE, true>(rsA, rs8, rsS, slw_e + m0, Outv, rows, base + m0, ncol0, rot, wid, lane, off8, off8, bwb, brd, rowidx, lds);
            else             moe_pass<MODE, 3, PROBE, true>(rsA, rs8, rsS, slw_e + m0, Outv, rows, base + m0, ncol0, rot, wid, lane, off8, off8, bwb, brd, rowidx, lds);
        } else if (cnt > TM) {
            moe_pass<MODE, 3, PROBE, false, true>(rsA, rsB, rsS, slw_e + m0, Outv, rows, base + m0, ncol0, rot, wid, lane, boff, off8, bwb, brd, rowidx, lds);
        } else {
            if (rows <= 256) moe_pass<MODE, 2, PROBE, false>(rsA, rsB, rsS, slw_e + m0, Outv, rows, base + m0, ncol0, rot, wid, lane, boff, off8, bwb, brd, rowidx, lds);
            else             moe_pass<MODE, 3, PROBE, false>(rsA, rsB, rsS, slw_e + m0, Outv, rows, base + m0, ncol0, rot, wid, lane, boff, off8, bwb, brd, rowidx, lds);
        }
    }
}
template <int MODE, int PROBE = 0>
__device__ __forceinline__ void moe_phase(const unsigned char* Asrc, const int* sltok, const float* slw, const float* Wa, const float* Wb, void* Out, const int* cntg, char* lds, int c, int G, unsigned char* svall, unsigned* qctr, const unsigned char* w8 = nullptr) {
    constexpr int NT = MODE == 0 ? 12 : 16;
    int* basel = (int*)(lds + LDS_BASE); int* ordl = (int*)lds; int* cstl = (int*)(lds + 256); int* nxtl = (int*)(lds + 512);
    const bool pre_ok = (MODE == 0 && w8 != nullptr && G == 256);
    int t0 = threadIdx.x; asm volatile("" : "+v"(t0));
    __syncthreads();
    if (t0 < 64) { int s = 0; for (int i = 0; i < t0; ++i) s += cntg[i * 64]; basel[t0] = s;
        const int e = t0; int cn = cntg[e * 64]; if ((PROBE & 128) && cn > 384) cn = 384;
        const int passes = (cn + TM - 1) / TM;
        int cost = MODE == 0 ? ((pre_ok && e * 12 + 11 < 544) ? 12 : 55) + (cn > 256 ? 10 : 7) + (passes > 1 ? (passes - 1) * 12 : 0) : 20 + (cn > 256 ? 8 : 5) + (passes > 1 ? (passes - 1) * 8 : 0);
        cstl[e] = cn > 0 ? cost : 0; }
    __syncthreads();
    if (t0 < 64) { const int my = cstl[t0]; int rank = 0; for (int i = 0; i < 64; ++i) { const int o = cstl[i]; rank += (o > my || (o == my && i < t0)) ? 1 : 0; } ordl[rank] = t0; }
    __syncthreads();
#define MOE_RUN_UNIT(e, j, cnt, base, q_) do { \
        if (MODE == 0) moe_unit<0, PROBE>(Asrc, sltok + (size_t)(e) * 8192, nullptr, Wa + (size_t)(e) * 2048 * 768 + (j) * 64, Wb + (size_t)(e) * 2048 * 768 + (j) * 64, Out, cnt, base, (j) * 64, 0, lds, (pre_ok && (e) * 12 + (j) < 544) ? w8 + (size_t)((e) * 12 + (j)) * (32 * 8192) : nullptr, svall + (size_t)c * (32 * 8192), q_, nxtl); \
        else moe_unit<1, PROBE>(Asrc, nullptr, slw + (size_t)(e) * 8192, Wa + (size_t)(e) * 768 * 2048 + (j) * 128, Wa + (size_t)(e) * 768 * 2048 + (j) * 128 + 64, Out, cnt, base, (j) * 128, 0, lds, nullptr, svall + (size_t)c * (32 * 8192), q_, nxtl); } while (0)
    if (G == 256) {
        const int x = c & 7; unsigned* q = qctr + x * 16;
        if (threadIdx.x == 0) *nxtl = (int)__hip_atomic_fetch_add(q, 1u, __ATOMIC_RELAXED, __HIP_MEMORY_SCOPE_AGENT);
        __syncthreads();
        int idx = __builtin_amdgcn_readfirstlane(*nxtl);
        while (idx < 8 * NT) {
            const int sI = idx / NT, j = idx % NT, e = __builtin_amdgcn_readfirstlane(ordl[8 * sI + ((sI & 1) ? 7 - x : x)]);
            int cnt = __builtin_amdgcn_readfirstlane(cntg[e * 64]); const int base = __builtin_amdgcn_readfirstlane(basel[e]); if ((PROBE & 128) && cnt > 384) cnt = 384;
            bool skip = cnt <= 0;
            if ((PROBE & 32) && !(e * 12 + j < 544)) skip = true;
            if ((PROBE & 64) && (e * 12 + j < 544)) skip = true;
            if (skip) { __syncthreads(); if (threadIdx.x == 0) *nxtl = (int)__hip_atomic_fetch_add(q, 1u, __ATOMIC_RELAXED, __HIP_MEMORY_SCOPE_AGENT); }
            else MOE_RUN_UNIT(e, j, cnt, base, q);
            __syncthreads();
            idx = __builtin_amdgcn_readfirstlane(*nxtl);
        }
    } else {
        for (int idx = c; idx < 64 * NT; idx += G) { const int e = idx / NT, j = idx % NT; const int cnt = cntg[e * 64], base = basel[e];
            if (cnt <= 0) continue;
            MOE_RUN_UNIT(e, j, cnt, base, (unsigned*)nullptr); }
    }
#undef MOE_RUN_UNIT
}
}

namespace {
constexpr int D = 2048, SEQ = 4096, NTOK = 8192, NCTX = 512, NROW = 8704;
constexpr int NH = 8, HQK = 192, HV = 128, NKEY = 4352;
constexpr int INP = 2368, NMOD = 12288;
constexpr int NEXP = 64, DE = 768, ECAP = 8192;
constexpr int HMLD = 2176;
constexpr int WIN_ROWS = 3584;
constexpr float EPS = 1e-6f;

__device__ __forceinline__ float bf2f(bf16_t b) { return __uint_as_float(((unsigned)b) << 16); }
__device__ __forceinline__ bf16_t f2bf(float f) { unsigned u = __float_as_uint(f); u += 0x7FFFu + ((u >> 16) & 1u); return (bf16_t)(u >> 16); }
__device__ __forceinline__ float wave_sum(float v) { for (int o = 32; o >= 1; o >>= 1) v += __shfl_xor(v, o); return v; }
__device__ __forceinline__ float wave_max(float v) { for (int o = 32; o >= 1; o >>= 1) v = fmaxf(v, __shfl_xor(v, o)); return v; }

constexpr size_t al256(size_t x) { return (x + 255) / 256 * 256; }
constexpr size_t WS_CTL   = 0;
constexpr size_t WS_MOD   = 65536;
constexpr size_t WS_WINT  = WS_MOD   + al256((size_t)3 * NMOD * 4);
constexpr size_t WS_WUQT  = WS_WINT  + al256((size_t)WIN_ROWS * D * 2);
constexpr size_t WS_WUKVT = WS_WUQT  + al256((size_t)1536 * 768 * 2);
constexpr size_t WS_WOUTT = WS_WUKVT + al256((size_t)2048 * 512 * 2);
constexpr size_t WS_HX    = WS_WOUTT + al256((size_t)2048 * 2048 * 2);
constexpr size_t WS_G     = WS_HX    + al256((size_t)NROW * D * 2);
constexpr size_t WS_QL    = WS_G     + al256((size_t)NTOK * 2048 * 2);
constexpr size_t WS_KVL   = WS_QL    + al256((size_t)NTOK * 768 * 2);
constexpr size_t WS_ROPEK = WS_KVL   + al256((size_t)NROW * 512 * 2);
constexpr size_t WS_RSTDQ = WS_ROPEK + al256((size_t)NROW * 64 * 2);
constexpr size_t WS_RSTDKV= WS_RSTDQ + al256((size_t)NROW * 4);
constexpr size_t WS_QRAW  = WS_RSTDKV+ al256((size_t)NROW * 4);
constexpr size_t WS_KNRAW = WS_QRAW  + al256((size_t)NTOK * 1536 * 2);
constexpr size_t WS_VF    = WS_KNRAW + al256((size_t)NROW * 1024 * 2);
constexpr size_t WS_QF    = WS_VF    + al256((size_t)2 * NH * NKEY * HV * 2);
constexpr size_t WS_KF    = WS_QF    + al256((size_t)2 * NH * SEQ * HQK * 2);
constexpr size_t WS_ATT   = WS_KF    + al256((size_t)2 * NH * NKEY * HQK * 2);
constexpr size_t WS_T1    = WS_ATT   + al256((size_t)NTOK * 1024 * 2);
constexpr size_t WS_Y     = WS_T1    + al256((size_t)NTOK * 2048 * 2);
constexpr size_t WS_MIXA  = WS_Y     + al256((size_t)NTOK * 1024 * 2);
constexpr size_t WS_HM    = WS_MIXA  + al256((size_t)NTOK * 2048 * 2);
constexpr size_t WS_TOKE  = WS_HM    + al256((size_t)NTOK * HMLD * 2);
constexpr size_t WS_TOKP  = WS_TOKE  + al256((size_t)NTOK * 2 * 4);
constexpr size_t WS_SLTOK = WS_TOKP  + al256((size_t)NTOK * 2 * 4);
constexpr size_t WS_SLW   = WS_SLTOK + al256((size_t)NEXP * ECAP * 4);
constexpr size_t WS_H     = WS_SLW   + al256((size_t)NEXP * ECAP * 4);
constexpr size_t WS_YS    = WS_H     + al256((size_t)16384 * DE * 2);
constexpr size_t WS_SSQP  = WS_YS    + al256((size_t)16384 * D * 2);
constexpr size_t WS_WF    = WS_SSQP  + al256((size_t)NROW * 20 * 4);
constexpr size_t WS_MT    = WS_WF    + al256((size_t)2048 * 1024 * 2);
constexpr size_t WS_WR    = WS_MT    + al256((size_t)512 * 256 * 2);
constexpr size_t WS_WRH   = WS_WR    + al256((size_t)2048 * 96 * 4);
constexpr size_t WS_WRL   = WS_WRH   + al256((size_t)80 * 2048 * 2);
constexpr size_t WS_AB    = WS_WRL   + al256((size_t)80 * 2048 * 2);
constexpr size_t WS_SHW   = WS_AB    + al256((size_t)2 * 2048 * 4);
constexpr size_t WS_SC    = WS_SHW   + al256((size_t)2 * 96 * 4);
constexpr size_t WS_END   = WS_SC    + al256((size_t)NH * SEQ * NKEY * 4);

__global__ void k_ada(const float* __restrict__ c, const float* __restrict__ cctx, const float* __restrict__ w, const float* __restrict__ b, float* __restrict__ mod) {
    __shared__ float sc[D];
    const int n = blockIdx.x * 256 + threadIdx.x, r = blockIdx.y;
    const float* cond = r < 2 ? c + r * D : cctx;
    for (int k = threadIdx.x; k < D; k += 256) { const float v = cond[k]; sc[k] = v / (1.f + expf(-v)); }
    __syncthreads();
    float acc = 0.f;
    for (int k = 0; k < D; ++k) acc += sc[k] * w[(size_t)k * NMOD + n];
    mod[r * NMOD + n] = acc + b[n];
}

__global__ void k_fold(const float* __restrict__ w_in, bf16_t* __restrict__ WinT) {
    __shared__ float tab[256];
    const int j = blockIdx.x, im = j >> 10, g = (j >> 8) & 3, kc = j & 255;
    { const int c = threadIdx.x, m = (c * kc) & 255; const float x = (float)m / 128.f; tab[c] = im ? -sinpif(x) : cospif(x); }
    __syncthreads();
    for (int k = threadIdx.x; k < D; k += 256) {
        const float* wr = w_in + (size_t)k * INP + g * 256; float acc = 0.f;
        for (int c = 0; c < 256; ++c) acc += wr[c] * tab[c];
        WinT[(size_t)j * D + k] = f2bf(acc);
    }
}

__global__ void k_tcvt(const float* __restrict__ in, const float* __restrict__ s0, const float* __restrict__ s1, bf16_t* __restrict__ out, int ldin, int coff, int K, int N, int ssplit, int ldo) {
    __shared__ float t[32][33];
    const int k0 = blockIdx.y * 32, n0 = blockIdx.x * 32, tx = threadIdx.x & 31, ty = threadIdx.x >> 5;
    for (int i = ty; i < 32; i += 8) { const int k = k0 + i, n = n0 + tx; float v = 0.f;
        if (k < K && n < N) { v = in[(size_t)k * ldin + coff + n]; if (s0) v *= (k < ssplit ? s0[k] : s1[k - ssplit]); }
        t[i][tx] = v; }
    __syncthreads();
    for (int i = ty; i < 32; i += 8) { const int n = n0 + i, k = k0 + tx; if (n < N && k < K) out[(size_t)n * ldo + k] = f2bf(t[tx][i]); }
}

__global__ void k_hx(const float* __restrict__ x, const float* __restrict__ ctx, const float* __restrict__ g1, const float* __restrict__ mod, bf16_t* __restrict__ HX) {
    const int row = blockIdx.x * 4 + (threadIdx.x >> 6), lane = threadIdx.x & 63;
    const float* src; int r;
    if (row < NTOK) { src = x + (size_t)row * D; r = row / SEQ; } else { src = ctx + (size_t)(row - NTOK) * D; r = 2; }
    float ss = 0.f;
    for (int i = 0; i < 8; ++i) { const float4 t = *(const float4*)(src + i * 256 + lane * 4); ss += t.x * t.x + t.y * t.y + t.z * t.z + t.w * t.w; }
    ss = wave_sum(ss); const float rstd = rsqrtf(ss / (float)D + EPS);
    const float* sh = mod + r * NMOD; const float* sc = sh + D;
    for (int i = 0; i < 8; ++i) { const int col = i * 256 + lane * 4; const float4 t = *(const float4*)(src + col);
        const float v[4] = {t.x, t.y, t.z, t.w}; bf16_t o[4];
#pragma unroll
        for (int j = 0; j < 4; ++j) o[j] = f2bf(v[j] * rstd * g1[col + j] * (1.f + sc[col + j]) + sh[col + j]);
        *(uint2*)(HX + (size_t)row * D + col) = make_uint2((unsigned)o[0] | ((unsigned)o[1] << 16), (unsigned)o[2] | ((unsigned)o[3] << 16)); }
}

template <bool BT, class FA, class FB, class FS>
__global__ __launch_bounds__(256) void gemm_naive(int M, int N, int K, int pad_, FA fa, FB fb, FS fs) {
    __shared__ float As[16][65], Bs[16][65];
    const int z = blockIdx.z, m0 = blockIdx.y * 64, n0 = blockIdx.x * 64, tx = threadIdx.x & 15, ty = threadIdx.x >> 4;
    float acc[4][4];
#pragma unroll
    for (int i = 0; i < 4; ++i)
#pragma unroll
        for (int j = 0; j < 4; ++j) acc[i][j] = 0.f;
    for (int k0 = 0; k0 < K; k0 += 16) {
#pragma unroll
        for (int i = 0; i < 4; ++i) { const int idx = threadIdx.x + i * 256, kk = idx & 15, mm = idx >> 4; As[kk][mm] = (m0 + mm < M) ? fa(z, m0 + mm, k0 + kk) : 0.f; }
#pragma unroll
        for (int i = 0; i < 4; ++i) { const int idx = threadIdx.x + i * 256; int kk, nn; if (BT) { kk = idx & 15; nn = idx >> 4; } else { nn = idx & 63; kk = idx >> 6; }
            Bs[kk][nn] = (n0 + nn < N) ? fb(z, k0 + kk, n0 + nn) : 0.f; }
        __syncthreads();
#pragma unroll
        for (int kk = 0; kk < 16; ++kk) { float a[4], b[4];
#pragma unroll
            for (int i = 0; i < 4; ++i) { a[i] = As[kk][ty * 4 + i]; b[i] = Bs[kk][tx * 4 + i]; }
#pragma unroll
            for (int i = 0; i < 4; ++i)
#pragma unroll
                for (int j = 0; j < 4; ++j) acc[i][j] += a[i] * b[j]; }
        __syncthreads();
    }
#pragma unroll
    for (int i = 0; i < 4; ++i)
#pragma unroll
        for (int j = 0; j < 4; ++j) { const int m = m0 + ty * 4 + i, n = n0 + tx * 4 + j; if (m < M && n < N) fs(z, m, n, acc[i][j]); }
}
struct LdBf { const bf16_t* p; size_t zs; int ld; int pad;
    __device__ float operator()(int z, int r, int c) const { return bf2f(p[z * zs + (size_t)r * ld + c]); } };
struct LdBfT { const bf16_t* p; size_t zs; int ld; int pad;
    __device__ float operator()(int z, int k, int n) const { return bf2f(p[z * zs + (size_t)n * ld + k]); } };
struct LdF { const float* p; size_t zs; int ld; int pad;
    __device__ float operator()(int z, int r, int c) const { return p[z * zs + (size_t)r * ld + c]; } };

struct StInproj { bf16_t *G, *QLb, *KVLb, *RK;
    __device__ void operator()(int, int m, int n, float v) const {
        if (n < 2048) { if (m < NTOK) G[(size_t)m * 2048 + n] = f2bf(v); }
        else if (n < 2816) { if (m < NTOK) QLb[(size_t)m * 768 + (n - 2048)] = f2bf(v); }
        else if (n < 3328) KVLb[(size_t)m * 512 + (n - 2816)] = f2bf(v);
        else RK[(size_t)m * 64 + (n - 3328)] = f2bf(v); } };
__global__ void k_rstd(const bf16_t* __restrict__ QLb, const bf16_t* __restrict__ KVLb, float* __restrict__ rq, float* __restrict__ rkv, float* __restrict__ SSQP) {
    const int row = blockIdx.x * 256 + threadIdx.x; if (row >= NROW) return;
    for (int i = 0; i < 20; ++i) SSQP[(size_t)row * 20 + i] = 0.f;
    if (row < NTOK) { float s = 0.f; for (int i = 0; i < 768; ++i) { const float v = bf2f(QLb[(size_t)row * 768 + i]); s += v * v; } rq[row] = rsqrtf(s / 768.f + EPS); SSQP[(size_t)row * 20] = s; }
    { float s = 0.f; for (int i = 0; i < 512; ++i) { const float v = bf2f(KVLb[(size_t)row * 512 + i]); s += v * v; } rkv[row] = rsqrtf(s / 512.f + EPS); SSQP[(size_t)row * 20 + 12] = s; }
}
struct StQ { bf16_t* Q; const float* rq; __device__ void operator()(int, int m, int n, float v) const { Q[(size_t)m * 1536 + n] = f2bf(v * rq[m]); } };
struct StKV { bf16_t *KN, *V; const float* rkv;
    __device__ void operator()(int, int m, int n, float v) const { const int h = n >> 8, j = n & 255; v *= rkv[m];
        if (j < 128) KN[(size_t)m * 1024 + h * 128 + j] = f2bf(v);
        else { int b, key; if (m < NTOK) { b = m >> 12; key = m & 4095; } else { b = (m - NTOK) >> 8; key = SEQ + ((m - NTOK) & 255); }
            V[((size_t)(b * NH + h) * NKEY + key) * HV + (j - 128)] = f2bf(v); } } };

__global__ void k_qkprep(const bf16_t* __restrict__ QRAW, const bf16_t* __restrict__ KNRAW, const bf16_t* __restrict__ RK, const float* __restrict__ gq, const float* __restrict__ gk,
                         bf16_t* __restrict__ Qf, bf16_t* __restrict__ Kf) {
    const int id = blockIdx.x * 256 + threadIdx.x;
    const int nq = NTOK * NH, nk = NROW * NH;
    if (id >= nq + nk) return;
    const bool isq = id < nq; const int it = isq ? id : id - nq; const int row = it >> 3, h = it & 7;
    const bf16_t* a = isq ? QRAW + (size_t)row * 1536 + h * 192 : KNRAW + (size_t)row * 1024 + h * 128;
    const bf16_t* r = isq ? a + 128 : RK + (size_t)row * 64;
    const float* g = isq ? gq : gk;
    float s = 0.f;
    for (int d = 0; d < 128; ++d) { const float v = bf2f(a[d]); s += v * v; }
    for (int d = 0; d < 64; ++d) { const float v = bf2f(r[d]); s += v * v; }
    const float rstd = rsqrtf(s / 192.f + EPS);
    int b, pos; const bool lat = row < NTOK;
    if (lat) { b = row >> 12; pos = row & 4095; } else { b = (row - NTOK) >> 8; pos = SEQ + ((row - NTOK) & 255); }
    bf16_t* o = isq ? Qf + ((size_t)(b * NH + h) * SEQ + pos) * HQK : Kf + ((size_t)(b * NH + h) * NKEY + pos) * HQK;
    for (int d = 0; d < 128; ++d) o[d] = f2bf(bf2f(a[d]) * rstd * g[d]);
    const int prow = (pos & 4095) >> 6, pcol = pos & 63;
    for (int e = 0; e < 64; ++e) {
        const float xe = bf2f(r[e]) * rstd * g[128 + e]; float outv = xe;
        if (lat) { const int ax = e >> 5, i = e & 31, f = i & 15; const float p = (float)(ax ? pcol : prow);
            const float inv = powf(10000.f, -(float)f / 16.f); const float ang = p * inv; const float cs = cosf(ang), sn = sinf(ang);
            if (i < 16) { const float x2 = bf2f(r[e + 16]) * rstd * g[128 + e + 16]; outv = xe * cs - x2 * sn; }
            else { const float x1 = bf2f(r[e - 16]) * rstd * g[128 + e - 16]; outv = x1 * sn + xe * cs; } }
        o[128 + e] = f2bf(outv); }
}

struct StF { float* p; size_t zs; int ld; int pad; __device__ void operator()(int z, int m, int n, float v) const { p[z * zs + (size_t)m * ld + n] = v; } };
__global__ void k_softmax(float* __restrict__ S) {
    const size_t row = (size_t)blockIdx.x * 4 + (threadIdx.x >> 6); const int lane = threadIdx.x & 63;
    float* p = S + row * NKEY; const float sc = 0.07216878364870323f;
    float mx = -1e30f; for (int i = lane; i < NKEY; i += 64) mx = fmaxf(mx, p[i] * sc); mx = wave_max(mx);
    float sum = 0.f; for (int i = lane; i < NKEY; i += 64) { const float e = expf(p[i] * sc - mx); p[i] = e; sum += e; } sum = wave_sum(sum);
    const float inv = 1.f / sum; for (int i = lane; i < NKEY; i += 64) p[i] *= inv;
}
struct StAtt { bf16_t* A; int b; int pad; __device__ void operator()(int z, int m, int n, float v) const { A[(size_t)(b * SEQ + m) * 1024 + z * 128 + n] = f2bf(v); } };

__global__ void k_dft1(const bf16_t* __restrict__ G, bf16_t* __restrict__ T1) {
    __shared__ float ct[64], st[64];
    if (threadIdx.x < 64) { ct[threadIdx.x] = cospif((float)threadIdx.x / 32.f); st[threadIdx.x] = sinpif((float)threadIdx.x / 32.f); }
    __syncthreads();
    const int col = blockIdx.x * 256 + threadIdx.x, orow = blockIdx.y, b = blockIdx.z, k1 = orow >> 6, n2 = orow & 63;
    float tr = 0.f, ti = 0.f;
    for (int n1 = 0; n1 < 64; ++n1) { const size_t ir = (size_t)(b * SEQ + 64 * n1 + n2) * 2048; const float zr = bf2f(G[ir + col]), zi = bf2f(G[ir + 1024 + col]);
        const int m = (n1 * k1) & 63; const float c = ct[m], s = st[m]; tr += zr * c + zi * s; ti += zi * c - zr * s; }
    const float x = (float)(n2 * k1) / 2048.f, c = cospif(x), s = sinpif(x);
    const size_t orw = (size_t)(b * SEQ + orow) * 2048;
    T1[orw + col] = f2bf(tr * c + ti * s); T1[orw + 1024 + col] = f2bf(ti * c - tr * s);
}
__global__ void k_dft2(const bf16_t* __restrict__ T1, bf16_t* __restrict__ Y) {
    __shared__ float ct[64], st[64];
    if (threadIdx.x < 64) { ct[threadIdx.x] = cospif((float)threadIdx.x / 32.f); st[threadIdx.x] = sinpif((float)threadIdx.x / 32.f); }
    __syncthreads();
    const int col = blockIdx.x * 256 + threadIdx.x, orow = blockIdx.y, b = blockIdx.z, k1 = orow & 63, k2 = orow >> 6;
    float acc = 0.f;
    for (int n2 = 0; n2 < 64; ++n2) { const size_t ir = (size_t)(b * SEQ + 64 * k1 + n2) * 2048; const int m = (n2 * k2) & 63;
        acc += bf2f(T1[ir + col]) * ct[m] + bf2f(T1[ir + 1024 + col]) * st[m]; }
    Y[(size_t)(b * SEQ + orow) * 1024 + col] = f2bf(acc * (1.f / 1024.f));
}
__global__ void k_mixnorm(const bf16_t* __restrict__ Y, const bf16_t* __restrict__ ATT, bf16_t* __restrict__ MIXA) {
    const int row = blockIdx.x * 4 + (threadIdx.x >> 6), lane = threadIdx.x & 63;
    float sf = 0.f, sa = 0.f;
    for (int i = lane; i < 1024; i += 64) { const float a = bf2f(Y[(size_t)row * 1024 + i]), c = bf2f(ATT[(size_t)row * 1024 + i]); sf += a * a; sa += c * c; }
    sf = wave_sum(sf); sa = wave_sum(sa);
    const float rf = rsqrtf(sf / 1024.f + EPS), ra = rsqrtf(sa / 1024.f + EPS);
    for (int i = lane; i < 1024; i += 64) { MIXA[(size_t)row * 2048 + i] = f2bf(bf2f(Y[(size_t)row * 1024 + i]) * rf); MIXA[(size_t)row * 2048 + 1024 + i] = f2bf(bf2f(ATT[(size_t)row * 1024 + i]) * ra); }
}
struct StOut { float* out; const float* x; const float* mod; __device__ void operator()(int, int m, int n, float v) const { const int b = m >> 12; out[(size_t)m * D + n] = x[(size_t)m * D + n] + mod[b * NMOD + 2 * D + n] * v; } };

__global__ void k_route(const float* __restrict__ xn, const float* __restrict__ g2, const float* __restrict__ mod, const float* __restrict__ wrg, const float* __restrict__ brg,
                        const float* __restrict__ wre, const float* __restrict__ bre, bf16_t* __restrict__ HM, int* __restrict__ cnt, int* __restrict__ toke, int* __restrict__ tokp,
                        int* __restrict__ sltok, float* __restrict__ slw) {
    __shared__ float hm[D]; __shared__ float red[4]; __shared__ float lg[72];
    const int t = blockIdx.x, b = t >> 12, tid = threadIdx.x;
    const float* src = xn + (size_t)t * D; float ss = 0.f;
    for (int k = tid; k < D; k += 256) { const float v = src[k]; ss += v * v; }
    ss = wave_sum(ss); if ((tid & 63) == 0) red[tid >> 6] = ss; __syncthreads();
    const float rstd = rsqrtf((red[0] + red[1] + red[2] + red[3]) / (float)D + EPS);
    const float* sh = mod + b * NMOD + 3 * D; const float* sc = mod + b * NMOD + 4 * D;
    for (int k = tid; k < D; k += 256) { const float v = src[k] * rstd * g2[k] * (1.f + sc[k]) + sh[k]; hm[k] = v; HM[(size_t)t * D + k] = f2bf(v); }
    __syncthreads();
    if (tid < 72) { float acc = 0.f;
        if (tid < 8) { for (int k = 0; k < D; ++k) acc += hm[k] * wrg[k * 8 + tid]; acc += brg[tid]; }
        else { const int j = tid - 8; for (int k = 0; k < D; ++k) acc += hm[k] * wre[k * 64 + j]; acc += bre[j]; }
        lg[tid] = acc; }
    __syncthreads();
    if (tid == 0) {
        int gi = 0; float gm = lg[0]; for (int j = 1; j < 8; ++j) if (lg[j] > gm) { gm = lg[j]; gi = j; }
        float gs = 0.f; for (int j = 0; j < 8; ++j) gs += expf(lg[j] - gm); const float gp = 1.f / gs;
        const float* el = lg + 8 + gi * 8;
        int i0 = 0; float m0 = el[0]; for (int j = 1; j < 8; ++j) if (el[j] > m0) { m0 = el[j]; i0 = j; }
        int i1 = -1; float m1 = -1e30f; for (int j = 0; j < 8; ++j) if (j != i0 && el[j] > m1) { m1 = el[j]; i1 = j; }
        const float r = expf(m1 - m0), p0 = 1.f / (1.f + r), p1 = r / (1.f + r);
        const int e0 = gi * 8 + i0, e1 = gi * 8 + i1;
        const int q0 = atomicAdd(&cnt[e0], 1), q1 = atomicAdd(&cnt[e1], 1);
        toke[t * 2] = e0; toke[t * 2 + 1] = e1; tokp[t * 2] = q0; tokp[t * 2 + 1] = q1;
        sltok[e0 * ECAP + q0] = t; sltok[e1 * ECAP + q1] = t; slw[e0 * ECAP + q0] = gp * p0; slw[e1 * ECAP + q1] = gp * p1; }
}

__global__ __launch_bounds__(256) void k_moe_up(const bf16_t* __restrict__ HM, const float* __restrict__ wg, const float* __restrict__ wu, const int* __restrict__ cnt, const int* __restrict__ sltok, bf16_t* __restrict__ H) {
    __shared__ float As[16][65], Bg[16][65], Bu[16][65]; __shared__ int toks[64];
    const int e = blockIdx.z, c = cnt[e], m0 = blockIdx.y * 64; if (m0 >= c) return;
    int base = 0; for (int i = 0; i < e; ++i) base += cnt[i];
    const int n0 = blockIdx.x * 64, tx = threadIdx.x & 15, ty = threadIdx.x >> 4;
    if (threadIdx.x < 64) toks[threadIdx.x] = (m0 + (int)threadIdx.x < c) ? sltok[e * ECAP + m0 + threadIdx.x] : -1;
    __syncthreads();
    const float* G = wg + (size_t)e * D * DE; const float* U = wu + (size_t)e * D * DE;
    float ag[4][4], au[4][4];
#pragma unroll
    for (int i = 0; i < 4; ++i)
#pragma unroll
        for (int j = 0; j < 4; ++j) { ag[i][j] = 0.f; au[i][j] = 0.f; }
    for (int k0 = 0; k0 < D; k0 += 16) {
#pragma unroll
        for (int i = 0; i < 4; ++i) { const int idx = threadIdx.x + i * 256, kk = idx & 15, mm = idx >> 4; const int tk = toks[mm]; As[kk][mm] = tk >= 0 ? bf2f(HM[(size_t)tk * D + k0 + kk]) : 0.f; }
#pragma unroll
        for (int i = 0; i < 4; ++i) { const int idx = threadIdx.x + i * 256, nn = idx & 63, kk = idx >> 6; Bg[kk][nn] = G[(size_t)(k0 + kk) * DE + n0 + nn]; Bu[kk][nn] = U[(size_t)(k0 + kk) * DE + n0 + nn]; }
        __syncthreads();
#pragma unroll
        for (int kk = 0; kk < 16; ++kk) { float a[4], bg[4], bu[4];
#pragma unroll
            for (int i = 0; i < 4; ++i) { a[i] = As[kk][ty * 4 + i]; bg[i] = Bg[kk][tx * 4 + i]; bu[i] = Bu[kk][tx * 4 + i]; }
#pragma unroll
            for (int i = 0; i < 4; ++i)
#pragma unroll
                for (int j = 0; j < 4; ++j) { ag[i][j] += a[i] * bg[j]; au[i][j] += a[i] * bu[j]; } }
        __syncthreads();
    }
#pragma unroll
    for (int i = 0; i < 4; ++i)
#pragma unroll
        for (int j = 0; j < 4; ++j) { const int m = m0 + ty * 4 + i, n = n0 + tx * 4 + j; if (m < c) { const float g = ag[i][j]; H[(size_t)(base + m) * DE + n] = f2bf(g / (1.f + expf(-g)) * au[i][j]); } }
}
__global__ __launch_bounds__(256) void k_moe_down(const bf16_t* __restrict__ H, const float* __restrict__ wd, const int* __restrict__ cnt, const float* __restrict__ slw, bf16_t* __restrict__ YS) {
    __shared__ float As[16][65], Bs[16][65];
    const int e = blockIdx.z, c = cnt[e], m0 = blockIdx.y * 64; if (m0 >= c) return;
    int base = 0; for (int i = 0; i < e; ++i) base += cnt[i];
    const int n0 = blockIdx.x * 64, tx = threadIdx.x & 15, ty = threadIdx.x >> 4;
    const float* W = wd + (size_t)e * DE * D;
    float acc[4][4];
#pragma unroll
    for (int i = 0; i < 4; ++i)
#pragma unroll
        for (int j = 0; j < 4; ++j) acc[i][j] = 0.f;
    for (int k0 = 0; k0 < DE; k0 += 16) {
#pragma unroll
        for (int i = 0; i < 4; ++i) { const int idx = threadIdx.x + i * 256, kk = idx & 15, mm = idx >> 4; As[kk][mm] = (m0 + mm < c) ? bf2f(H[(size_t)(base + m0 + mm) * DE + k0 + kk]) : 0.f; }
#pragma unroll
        for (int i = 0; i < 4; ++i) { const int idx = threadIdx.x + i * 256, nn = idx & 63, kk = idx >> 6; Bs[kk][nn] = W[(size_t)(k0 + kk) * D + n0 + nn]; }
        __syncthreads();
#pragma unroll
        for (int kk = 0; kk < 16; ++kk) { float a[4], b[4];
#pragma unroll
            for (int i = 0; i < 4; ++i) { a[i] = As[kk][ty * 4 + i]; b[i] = Bs[kk][tx * 4 + i]; }
#pragma unroll
            for (int i = 0; i < 4; ++i)
#pragma unroll
                for (int j = 0; j < 4; ++j) acc[i][j] += a[i] * b[j]; }
        __syncthreads();
    }
#pragma unroll
    for (int i = 0; i < 4; ++i)
#pragma unroll
        for (int j = 0; j < 4; ++j) { const int m = m0 + ty * 4 + i, n = n0 + tx * 4 + j; if (m < c) YS[(size_t)(base + m) * D + n] = f2bf(acc[i][j] * slw[e * ECAP + m]); }
}
__global__ void k_combine(float* __restrict__ out, const float* __restrict__ mod, const bf16_t* __restrict__ YS, const int* __restrict__ cnt, const int* __restrict__ toke, const int* __restrict__ tokp) {
    __shared__ int base[NEXP];
    if (threadIdx.x == 0) { int s = 0; for (int i = 0; i < NEXP; ++i) { base[i] = s; s += cnt[i]; } }
    __syncthreads();
    const int t = blockIdx.x, b = t >> 12;
    const int s0 = base[toke[t * 2]] + tokp[t * 2], s1 = base[toke[t * 2 + 1]] + tokp[t * 2 + 1];
    const float* gt = mod + b * NMOD + 5 * D;
    for (int n = threadIdx.x; n < D; n += 256) out[(size_t)t * D + n] += gt[n] * (bf2f(YS[(size_t)s0 * D + n]) + bf2f(YS[(size_t)s1 * D + n]));
}

#if 0
__global__ __launch_bounds__(512, 2) void k_g_inproj(pg8::Gemm g, pg8::EpiInproj E) {
    extern __shared__ __attribute__((aligned(16))) unsigned char shm[];
    pg8::OrdInproj S; S.G = (int)gridDim.x; S.c = (int)blockIdx.x;
    pg8::gemm_phase<pg8::EpiInproj, pg8::OrdInproj, false>((PG8_LAS unsigned char*)shm, g, S, E, nullptr);
}
__global__ __launch_bounds__(512, 2) void k_g_qkv(pg8::Gemm gq, pg8::EpiQ Eq, pg8::Gemm gkv, pg8::EpiKV Ekv) {
    extern __shared__ __attribute__((aligned(16))) unsigned char shm[];
    { pg8::OrdGrid S; S.nM = 32; S.nN = 6; S.G = (int)gridDim.x; S.c = (int)blockIdx.x; if ((int)blockIdx.x < 192) pg8::gemm_phase<pg8::EpiQ, pg8::OrdGrid, false>((PG8_LAS unsigned char*)shm, gq, S, Eq, nullptr); }
    __syncthreads();
    { pg8::OrdKV S; S.c = (int)blockIdx.x; pg8::gemm_phase<pg8::EpiKV, pg8::OrdKV, false>((PG8_LAS unsigned char*)shm, gkv, S, Ekv, nullptr); }
}
__global__ __launch_bounds__(512, 2) void k_g_out(pg8::Gemm g, pg8::EpiOut E) {
    extern __shared__ __attribute__((aligned(16))) unsigned char shm[];
    pg8::OrdGrid S; S.nM = 32; S.nN = 8; S.G = (int)gridDim.x; S.c = (int)blockIdx.x;
    pg8::gemm_phase<pg8::EpiOut, pg8::OrdGrid, false>((PG8_LAS unsigned char*)shm, g, S, E, nullptr);
}

#endif
__device__ __forceinline__ void attn_phase(const bf16_t* Qf, const bf16_t* Kf, const bf16_t* Vf, bf16_t* ATT, char* lds, int c, int G, const float* wg, const float* wu, unsigned char* w8) {
    for (int u = c; u < 256; u += G) {
        const att::SideJob sj{wg, wu, w8, u * 68, G == 256 ? 17408 : 0};
        const int x = u & 7, j = u >> 3, pair = 2 * x + (j >> 4), qb = j & 15, b = pair >> 3, h = pair & 7;
        att::attn_body(Qf + ((size_t)pair * SEQ + qb * 256) * HQK, Kf + (size_t)pair * NKEY * HQK, Vf + (size_t)pair * NKEY * HV,
                       ATT + ((size_t)(b * SEQ + qb * 256)) * 1024 + h * 128, 1024, NKEY, lds, sj);
    }
}
#if 0
__global__ __launch_bounds__(512, 2) void k_attn(const bf16_t* Qf, const bf16_t* Kf, const bf16_t* Vf, bf16_t* ATT) {
    extern __shared__ __attribute__((aligned(16))) unsigned char shm[];
    attn_phase(Qf, Kf, Vf, ATT, (char*)shm, (int)blockIdx.x, (int)gridDim.x);
}

__global__ __launch_bounds__(512, 2) void k_moe_up_opt(const bf16_t* HM, const int* sltok, const float* wg, const float* wu, bf16_t* H, const int* cnt) {
    extern __shared__ __attribute__((aligned(16))) unsigned char shm[];
    moe::moe_phase<0>(HM, sltok, nullptr, wg, wu, H, cnt, (char*)shm, (int)blockIdx.x, (int)gridDim.x);
}
__global__ __launch_bounds__(512, 2) void k_moe_down_opt(const bf16_t* H, const float* slw, const float* wd, bf16_t* YS, const int* cnt) {
    extern __shared__ __attribute__((aligned(16))) unsigned char shm[];
    moe::moe_phase<1>(H, nullptr, slw, wd, nullptr, YS, cnt, (char*)shm, (int)blockIdx.x, (int)gridDim.x);
}
__global__ void k_rstd2(const float* __restrict__ SSQP, float* __restrict__ rq, float* __restrict__ rkv) {
    const int row = blockIdx.x * 256 + threadIdx.x; if (row >= NROW) return;
    const float* p = SSQP + (size_t)row * 20; float a = 0.f, b = 0.f;
    for (int i = 0; i < 12; ++i) a += p[i]; for (int i = 12; i < 20; ++i) b += p[i];
    rq[row] = rsqrtf(a / 768.f + EPS); rkv[row] = rsqrtf(b / 512.f + EPS);
}

#endif
#define XB_TMO      128
#define XB_XCNT(j)  (256  + 64 * (j))
#define XB_XSUB(j)  (1280 + 64 * (j))
#define XB_XGEN(j)  (2304 + 64 * (j))
#define XB_TOP      3328
#define XB_TOPGEN   3392
#define XCD_BAR_WORDS 3456
#define XB_SPIN_CAP (1u << 18)
#define LAS __attribute__((address_space(3)))
__device__ __forceinline__ unsigned xb_ld(unsigned* p)              { return __hip_atomic_load(p, __ATOMIC_RELAXED, __HIP_MEMORY_SCOPE_AGENT); }
__device__ __forceinline__ unsigned xb_add(unsigned* p, unsigned v) { return __hip_atomic_fetch_add(p, v, __ATOMIC_RELAXED, __HIP_MEMORY_SCOPE_AGENT); }
__device__ __forceinline__ unsigned xb_xcc_id() { return (unsigned)__builtin_amdgcn_s_getreg((3 << 11) | 20) & 0xFu; }
#define XB_SPIN(cond, bar) do { unsigned _sp = 0; while (cond) { __builtin_amdgcn_s_sleep(1); \
    if ((++_sp & 255u) == 0u) { if (xb_ld(&(bar)[XB_TMO])) break; if (_sp > XB_SPIN_CAP) { atomicAdd(&(bar)[XB_TMO], 1u); break; } } } } while (0)
struct XcdBarrier { unsigned* bar; unsigned x; volatile LAS unsigned* st; };
__device__ __forceinline__ XcdBarrier xcd_barrier_post(unsigned* bar, volatile LAS unsigned* st) {
    XcdBarrier b; b.bar = bar; b.x = xb_xcc_id(); b.st = st;
    if (threadIdx.x == 0) (void)xb_add(&bar[XB_XCNT(b.x)], 1u);
    return b;
}
__device__ __forceinline__ void xcd_barrier_complete(unsigned* bar, unsigned x, unsigned& nloc, unsigned& nx) {
    const unsigned G = gridDim.x * gridDim.y * gridDim.z;
    unsigned sum, cnt, mine, sp = 0u;
    for (;;) {
        sum = 0u; cnt = 0u; mine = 0u;
#pragma unroll
        for (unsigned j = 0; j < 16; ++j) { const unsigned c = xb_ld(&bar[XB_XCNT(j)]); sum += c; cnt += (c > 0u) ? 1u : 0u; mine = (j == x) ? c : mine; }
        if (sum == G) break;
        __builtin_amdgcn_s_sleep(1);
        if ((++sp & 255u) == 0u) { if (xb_ld(&bar[XB_TMO])) break; if (sp > XB_SPIN_CAP) { atomicAdd(&bar[XB_TMO], 1u); break; } }
    }
    nloc = mine > 0u ? mine : 1u; nx = cnt > 0u ? cnt : 1u;
}
__device__ __forceinline__ void xcd_barrier(const XcdBarrier& b) {
    asm volatile("s_waitcnt vmcnt(0)" ::: "memory");
    __syncthreads();
    if (threadIdx.x == 0) {
        unsigned* bar = b.bar;
        __builtin_amdgcn_s_waitcnt(0);
        unsigned nloc = b.st[0], nx = b.st[1];
        if (nloc == 0u) { xcd_barrier_complete(bar, b.x, nloc, nx); b.st[0] = nloc; b.st[1] = nx; }
        const unsigned old = xb_add(&bar[XB_XSUB(b.x)], 1u);
        const unsigned gen = old / nloc;
        if (old + 1u == (gen + 1u) * nloc) {
            __builtin_amdgcn_fence(__ATOMIC_RELEASE, "agent");
            asm volatile("s_waitcnt vmcnt(0)" ::: "memory");
            const unsigned og = xb_add(&bar[XB_TOP], 1u);
            const unsigned tg = og / nx;
            if (og + 1u == (tg + 1u) * nx) xb_add(&bar[XB_TOPGEN], 1u);
            else XB_SPIN(xb_ld(&bar[XB_TOPGEN]) == tg, bar);
            __builtin_amdgcn_fence(__ATOMIC_ACQUIRE, "agent");
            xb_add(&bar[XB_XGEN(b.x)], 1u);
            asm volatile("s_waitcnt vmcnt(0)" ::: "memory");
        } else {
            XB_SPIN(xb_ld(&bar[XB_XGEN(b.x)]) == gen, bar);
            __builtin_amdgcn_fence(__ATOMIC_ACQUIRE, "agent");
            asm volatile("s_waitcnt vmcnt(0)" ::: "memory");
        }
    }
    __syncthreads();
}

namespace dft {
using u32x4 = __attribute__((ext_vector_type(4))) unsigned;
using bf16x8 = __attribute__((ext_vector_type(8))) short;
using s16x4  = __attribute__((ext_vector_type(4))) short;
using f32x16 = __attribute__((ext_vector_type(16))) float;
constexpr int ROWB = 320, LDS_BYTES = 128 * ROWB;
__device__ __forceinline__ int crow(int r, int hi) { return (r & 3) + 8 * (r >> 2) + 4 * hi; }
__device__ __forceinline__ unsigned cvtpk(float lo, float hi) { unsigned r; asm volatile("v_cvt_pk_bf16_f32 %0, %1, %2" : "=v"(r) : "v"(lo), "v"(hi)); return r; }
template <int OFF> __device__ __forceinline__ s16x4 tr_read(int vb) { s16x4 r; asm volatile("ds_read_b64_tr_b16 %0, %1 offset:%2" : "=&v"(r) : "v"(vb), "i"(OFF) : "memory"); return r; }
template <int KS> __device__ __forceinline__ bf16x8 bfrag(int vb) {
    const s16x4 l = tr_read<KS * 16 * ROWB>(vb), h = tr_read<KS * 16 * ROWB + 4 * ROWB>(vb);
    asm volatile("s_waitcnt lgkmcnt(0)" ::: "memory"); __builtin_amdgcn_sched_barrier(0);
    return (bf16x8){l[0], l[1], l[2], l[3], h[0], h[1], h[2], h[3]};
}
template <int STAGE>
__device__ __forceinline__ void phase(const bf16_t* __restrict__ in, bf16_t* __restrict__ out, char* lds, int c, int G) {
    const int tid = threadIdx.x, wid = __builtin_amdgcn_readfirstlane(tid >> 6), lane = tid & 63, r32 = lane & 31, hi = lane >> 5, kt = wid & 1, ct = wid >> 1;
    bf16x8 Are[8], Aim[8];
#pragma unroll
    for (int ks = 0; ks < 8; ++ks) { unsigned wr_[4], wi_[4];
#pragma unroll
        for (int j2 = 0; j2 < 4; ++j2) { float cr[2], ci[2];
#pragma unroll
            for (int e = 0; e < 2; ++e) { const int idx = 16 * ks + 8 * hi + 2 * j2 + e, n = idx & 63, m = ((32 * kt + r32) * n) & 63;
                const float cs = cospif((float)m / 32.f), sn = sinpif((float)m / 32.f);
                cr[e] = idx < 64 ? cs : sn; ci[e] = idx < 64 ? -sn : cs; }
            wr_[j2] = cvtpk(cr[0], cr[1]); wi_[j2] = cvtpk(ci[0], ci[1]); }
        Are[ks] = *reinterpret_cast<bf16x8*>(wr_); Aim[ks] = *reinterpret_cast<bf16x8*>(wi_); }
    const int q = (lane & 15) >> 2, p = lane & 3, g16 = (lane >> 4) & 1;
    const int vb = (int)(uintptr_t)lds + (8 * hi + q) * ROWB + (32 * ct + 16 * g16 + 4 * p) * 2;
    u32x4 pre[4];
#define DFT_LOAD(tt) do { const int b_ = (tt) >> 9, r_ = ((tt) >> 3) & 63, cc_ = (tt) & 7; _Pragma("unroll") for (int i = 0; i < 4; ++i) { const int id = tid + 512 * i, lrow = id >> 4, ch = id & 15, part = lrow >> 6, m = lrow & 63; \
        const int grow = b_ * 4096 + (STAGE == 1 ? 64 * m + r_ : 64 * r_ + m); pre[i] = *(const u32x4*)(in + (size_t)grow * 2048 + part * 1024 + cc_ * 128 + ch * 8); } } while (0)
    if (c < 1024) DFT_LOAD(c);
    for (int t = c; t < 1024; t += G) {
        const int b = t >> 9, r = (t >> 3) & 63, cc = t & 7;
        __syncthreads();
#pragma unroll
        for (int i = 0; i < 4; ++i) { const int id = tid + 512 * i; *(u32x4*)(lds + (id >> 4) * ROWB + (id & 15) * 16) = pre[i]; }
        __syncthreads();
        { const int tn = t + G < 1024 ? t + G : t; DFT_LOAD(tn); }
        f32x16 are = {}, aim = {};
#define DFT_STEP(KS) do { const bf16x8 bb = bfrag<KS>(vb); are = __builtin_amdgcn_mfma_f32_32x32x16_bf16(Are[KS], bb, are, 0, 0, 0); \
        if (STAGE == 1) aim = __builtin_amdgcn_mfma_f32_32x32x16_bf16(Aim[KS], bb, aim, 0, 0, 0); } while (0)
        DFT_STEP(0); DFT_STEP(1); DFT_STEP(2); DFT_STEP(3); DFT_STEP(4); DFT_STEP(5); DFT_STEP(6); DFT_STEP(7);
#undef DFT_STEP
        __syncthreads();
        bf16_t* ol = (bf16_t*)lds;
#pragma unroll
        for (int rr = 0; rr < 16; ++rr) { const int ko = 32 * kt + crow(rr, hi), lc = 32 * ct + r32;
            if (STAGE == 1) { const float ph = (float)(r * ko) / 2048.f, cs = cospif(ph), sn = sinpif(ph), tr = are[rr], ti = aim[rr];
                ol[ko * (ROWB / 2) + lc] = (bf16_t)(cvtpk(tr * cs + ti * sn, 0.f) & 0xffffu); ol[(64 + ko) * (ROWB / 2) + lc] = (bf16_t)(cvtpk(ti * cs - tr * sn, 0.f) & 0xffffu); }
            else ol[ko * (ROWB / 2) + lc] = (bf16_t)(cvtpk(are[rr] * (1.f / 1024.f), 0.f) & 0xffffu); }
        __syncthreads();
        if (STAGE == 1) {
#pragma unroll
            for (int i = 0; i < 4; ++i) { const int id = tid + 512 * i, lrow = id >> 4, ch = id & 15, part = lrow >> 6, ko = lrow & 63;
                *(u32x4*)(out + (size_t)(b * 4096 + 64 * ko + r) * 2048 + part * 1024 + cc * 128 + ch * 8) = *(const u32x4*)(lds + lrow * ROWB + ch * 16); }
        } else {
#pragma unroll
            for (int i = 0; i < 2; ++i) { const int id = tid + 512 * i, k2 = id >> 4, ch = id & 15;
                *(u32x4*)(out + (size_t)(b * 4096 + r + 64 * k2) * 1024 + cc * 128 + ch * 8) = *(const u32x4*)(lds + k2 * ROWB + ch * 16); }
        }
    }
#undef DFT_LOAD
}
}

namespace mk {
using f32x4 = __attribute__((ext_vector_type(4))) float;
using f32x16 = __attribute__((ext_vector_type(16))) float;
using u32x4 = __attribute__((ext_vector_type(4))) unsigned;
struct Params {
    const float *x, *c, *ctx, *cctx, *w_ada, *b_ada, *g1, *g2, *w_in, *g_q_a, *g_kv_a, *w_uq, *w_ukv, *g_qk_q, *g_qk_k, *g_of, *g_oa, *w_out, *w_rg, *b_rg, *w_re, *b_re, *w_gate, *w_up, *w_down;
    float* out; char* ws;
};
constexpr int LDS_XB = 0, LDS_PH = 64;
constexpr int LDS_PHASE_MAX = 132864;
constexpr int LDS_TOTAL = LDS_PH + LDS_PHASE_MAX;
__device__ __forceinline__ unsigned cvtpk(float lo, float hi) { unsigned r; asm volatile("v_cvt_pk_bf16_f32 %0, %1, %2" : "=v"(r) : "v"(lo), "v"(hi)); return r; }
__device__ __forceinline__ float bflo(unsigned w) { return __uint_as_float(w << 16); }
__device__ __forceinline__ float bfhi(unsigned w) { return __uint_as_float(w & 0xffff0000u); }

__device__ __forceinline__ void ada_unit(const Params& P, float* mod, int u, char* lds) {
    float* sc = (float*)lds; float* red = sc + 3 * 2048;
    const int tid = threadIdx.x;
    __syncthreads();
    for (int i = tid; i < 3 * 2048; i += 512) { const int r = i >> 11, k = i & 2047; const float v = r < 2 ? P.c[r * 2048 + k] : P.cctx[k]; sc[i] = v / (1.f + __expf(-v)); }
    __syncthreads();
    const int tq = tid & 15, ks = tid >> 4;
    const float* wp = P.w_ada + (size_t)(ks * 64) * 12288 + u * 64 + tq * 4;
    f32x4 a0 = {0.f, 0.f, 0.f, 0.f}, a1 = a0, a2 = a0;
#pragma unroll 16
    for (int kk = 0; kk < 64; ++kk) { const f32x4 wv = *(const f32x4*)(wp + (size_t)kk * 12288); const int k = ks * 64 + kk; a0 += wv * sc[k]; a1 += wv * sc[2048 + k]; a2 += wv * sc[4096 + k]; }
    float* rp = red + (ks * 16 + tq) * 12;
    *(f32x4*)(rp) = a0; *(f32x4*)(rp + 4) = a1; *(f32x4*)(rp + 8) = a2;
    __syncthreads();
    if (tid < 192) { const int r = tid >> 6, col = tid & 63, q4 = col >> 2, j = col & 3; float s = 0.f;
        for (int k2 = 0; k2 < 32; ++k2) s += red[(k2 * 16 + q4) * 12 + r * 4 + j];
        mod[r * 12288 + u * 64 + col] = s + P.b_ada[u * 64 + col]; }
}
struct TcvtDesc { const float* in; const float* s0; const float* s1; bf16_t* out; int ldin, coff, ssplit, ldo, k0, n0; };
__device__ __forceinline__ TcvtDesc tcvt_desc(const Params& P, char* ws, int j) {
    TcvtDesc d;
    if (j < 672) { d.in = P.w_in; d.ldin = INP; d.coff = 1024; d.s0 = nullptr; d.s1 = nullptr; d.ssplit = 0; d.out = (bf16_t*)(ws + WS_WINT) + (size_t)2048 * D; d.ldo = D; d.k0 = (j / 21) * 64; d.n0 = (j % 21) * 64; }
    else if (j < 960) { const int q = j - 672; d.in = P.w_uq; d.ldin = 1536; d.coff = 0; d.s0 = P.g_q_a; d.s1 = P.g_q_a; d.ssplit = 768; d.out = (bf16_t*)(ws + WS_WUQT); d.ldo = 768; d.k0 = (q / 24) * 64; d.n0 = (q % 24) * 64; }
    else if (j < 1216) { const int q = j - 960; d.in = P.w_ukv; d.ldin = 2048; d.coff = 0; d.s0 = P.g_kv_a; d.s1 = P.g_kv_a; d.ssplit = 512; d.out = (bf16_t*)(ws + WS_WUKVT); d.ldo = 512; d.k0 = (q / 32) * 64; d.n0 = (q % 32) * 64; }
    else { const int q = j - 1216; d.in = P.w_out; d.ldin = 2048; d.coff = 0; d.s0 = P.g_of; d.s1 = P.g_oa; d.ssplit = 1024; d.out = (bf16_t*)(ws + WS_WOUTT); d.ldo = 2048; d.k0 = (q / 32) * 64; d.n0 = (q % 32) * 64; }
    return d;
}
__device__ __forceinline__ void tcvt_load(const TcvtDesc& d, f32x4 (&v)[2]) {
    const int tid = threadIdx.x, r = tid >> 4, c4 = (tid & 15) * 4;
#pragma unroll
    for (int i = 0; i < 2; ++i) v[i] = *(const f32x4*)(d.in + (size_t)(d.k0 + r + 32 * i) * d.ldin + d.coff + d.n0 + c4);
}
__device__ __forceinline__ void tcvt_finish(const TcvtDesc& d, const f32x4 (&v)[2], char* lds) {
    float* t = (float*)lds;
    const int tid = threadIdx.x, r = tid >> 4, c4 = (tid & 15) * 4;
    __syncthreads();
#pragma unroll
    for (int i = 0; i < 2; ++i) { const int k = d.k0 + r + 32 * i; f32x4 x = v[i];
        if (d.s0) x *= (k < d.ssplit ? d.s0[k] : d.s1[k - d.ssplit]);
        float* tp = t + (r + 32 * i) * 65 + c4; tp[0] = x[0]; tp[1] = x[1]; tp[2] = x[2]; tp[3] = x[3]; }
    __syncthreads();
    const int n = tid >> 3, k8 = (tid & 7) * 8; float e[8];
#pragma unroll
    for (int j = 0; j < 8; ++j) e[j] = t[(k8 + j) * 65 + n];
    u32x4 w; w.x = cvtpk(e[0], e[1]); w.y = cvtpk(e[2], e[3]); w.z = cvtpk(e[4], e[5]); w.w = cvtpk(e[6], e[7]);
    *(u32x4*)(d.out + (size_t)(d.n0 + n) * d.ldo + d.k0 + k8) = w;
}
__device__ __forceinline__ void tcvt_tiles(const Params& P, char* ws, char* lds, int first, int stride, int hi) {
    if (first >= hi) return;
    TcvtDesc cur = tcvt_desc(P, ws, first); f32x4 v[2]; tcvt_load(cur, v);
    for (int j = first; j < hi; j += stride) { const int jn = j + stride < hi ? j + stride : j; const TcvtDesc nxt = tcvt_desc(P, ws, jn); f32x4 vn[2]; tcvt_load(nxt, vn);
        __builtin_amdgcn_sched_barrier(0);
        tcvt_finish(cur, v, lds); cur = nxt; v[0] = vn[0]; v[1] = vn[1]; }
    __syncthreads();
}
__device__ __forceinline__ void tcvt_range(const Params& P, char* ws, char* lds, int c, int G, int hi) { tcvt_tiles(P, ws, lds, c, G, hi); }
__device__ __forceinline__ void p0_jobs(const Params& P, char* lds, int c, int G) {
    char* ws = P.ws; const int tid = threadIdx.x;
    bf16_t* WinT = (bf16_t*)(ws + WS_WINT);
    bf16_t* WF = (bf16_t*)(ws + WS_WF); bf16_t* MT = (bf16_t*)(ws + WS_MT); float* WR = (float*)(ws + WS_WR);
    tcvt_range(P, ws, lds, c, G, 1216);
    const int gt = c * 512 + tid, gs = G * 512;
    for (int i = gt; i < 2048 * 128; i += gs) { const int k = i >> 7, c8 = (i & 127) * 8; const float* sp = P.w_in + (size_t)k * INP + c8;
        const f32x4 a = *(const f32x4*)sp, b = *(const f32x4*)(sp + 4); u32x4 w; w.x = cvtpk(a[0], a[1]); w.y = cvtpk(a[2], a[3]); w.z = cvtpk(b[0], b[1]); w.w = cvtpk(b[2], b[3]);
        *(u32x4*)(WF + (size_t)k * 1024 + c8) = w; }
    for (int i = gt; i < 512 * 32; i += gs) { const int jr = i >> 5, c8 = (i & 31) * 8, im = jr >> 8, kc = jr & 255; float e[8];
#pragma unroll
        for (int j = 0; j < 8; ++j) { const int m = ((c8 + j) * kc) & 255; const float xx = (float)m / 128.f; e[j] = im ? -sinpif(xx) : cospif(xx); }
        u32x4 w; w.x = cvtpk(e[0], e[1]); w.y = cvtpk(e[2], e[3]); w.z = cvtpk(e[4], e[5]); w.w = cvtpk(e[6], e[7]);
        *(u32x4*)(MT + (size_t)jr * 256 + c8) = w; }
    for (int i = gt; i < 2048 * 96; i += gs) { const int k = i / 96, j = i % 96; WR[i] = j < 8 ? P.w_rg[k * 8 + j] : (j < 72 ? P.w_re[k * 64 + (j - 8)] : 0.f); }
    { bf16_t* WRH = (bf16_t*)(ws + WS_WRH); bf16_t* WRL = (bf16_t*)(ws + WS_WRL);
      for (int i = gt; i < 80 * 256; i += gs) { const int o = i >> 8, k8 = (i & 255) * 8; float e[8]; unsigned hb[4], lb[4];
#pragma unroll
        for (int j = 0; j < 8; ++j) e[j] = o < 8 ? P.w_rg[(k8 + j) * 8 + o] : (o < 72 ? P.w_re[(k8 + j) * 64 + (o - 8)] : 0.f);
#pragma unroll
        for (int j = 0; j < 4; ++j) { hb[j] = cvtpk(e[2 * j], e[2 * j + 1]); lb[j] = cvtpk(e[2 * j] - bflo(hb[j]), e[2 * j + 1] - bfhi(hb[j])); }
        *(u32x4*)(WRH + (size_t)o * 2048 + k8) = (u32x4){hb[0], hb[1], hb[2], hb[3]}; *(u32x4*)(WRL + (size_t)o * 2048 + k8) = (u32x4){lb[0], lb[1], lb[2], lb[3]}; } }
    for (int i = gt; i < 192 * 2048 / 8; i += gs) *(u32x4*)(WinT + (size_t)3392 * D + (size_t)i * 8) = (u32x4){0u, 0u, 0u, 0u};
    if (c == 0 && tid < 64) ((int*)(ws + WS_CTL))[4096 + tid * 64] = 0;
}
__device__ __forceinline__ void hx_rows(const Params& P, const float* mod, bf16_t* HX, int c, int G) {
    int tid = threadIdx.x; asm volatile("" : "+v"(tid)); const int lane = tid & 63, stride = G * 8;
    for (int row0 = c * 8 + (tid >> 6); row0 < NROW; row0 += 2 * stride) {
        const int row1 = row0 + stride; const bool has1 = row1 < NROW; const int rr1 = has1 ? row1 : row0;
        const float* src0 = row0 < NTOK ? P.x + (size_t)row0 * D : P.ctx + (size_t)(row0 - NTOK) * D;
        const float* src1 = rr1 < NTOK ? P.x + (size_t)rr1 * D : P.ctx + (size_t)(rr1 - NTOK) * D;
        f32x4 v0[8], v1[8]; float ss0 = 0.f, ss1 = 0.f;
#pragma unroll
        for (int i = 0; i < 8; ++i) { v0[i] = *(const f32x4*)(src0 + i * 256 + lane * 4); v1[i] = *(const f32x4*)(src1 + i * 256 + lane * 4); }
#pragma unroll
        for (int i = 0; i < 8; ++i) { ss0 += (v0[i][0] * v0[i][0] + v0[i][1] * v0[i][1]) + (v0[i][2] * v0[i][2] + v0[i][3] * v0[i][3]); ss1 += (v1[i][0] * v1[i][0] + v1[i][1] * v1[i][1]) + (v1[i][2] * v1[i][2] + v1[i][3] * v1[i][3]); }
        const float rs0 = rsqrtf(wave_sum(ss0) * (1.f / 2048.f) + EPS), rs1 = rsqrtf(wave_sum(ss1) * (1.f / 2048.f) + EPS);
        const float* sh0 = mod + (row0 < NTOK ? row0 >> 12 : 2) * NMOD; const float* sh1 = mod + (rr1 < NTOK ? rr1 >> 12 : 2) * NMOD;
#pragma unroll
        for (int rr = 0; rr < 2; ++rr) { if (rr == 1 && !has1) break;
            const float* shp = rr ? sh1 : sh0; const float rs = rr ? rs1 : rs0; bf16_t* dst = HX + (size_t)(rr ? row1 : row0) * D; f32x4 gv[8], s1v[8], s0v[8];
#pragma unroll
            for (int i = 0; i < 8; ++i) { const int col = i * 256 + lane * 4; gv[i] = *(const f32x4*)(P.g1 + col); s1v[i] = *(const f32x4*)(shp + D + col); s0v[i] = *(const f32x4*)(shp + col); }
            __builtin_amdgcn_sched_barrier(0);
#pragma unroll
            for (int i = 0; i < 8; ++i) { const int col = i * 256 + lane * 4; const f32x4 o = (rr ? v1[i] : v0[i]) * rs * gv[i] * (s1v[i] + 1.f) + s0v[i]; uint2 w; w.x = cvtpk(o[0], o[1]); w.y = cvtpk(o[2], o[3]); *(uint2*)(dst + col) = w; }
            __builtin_amdgcn_sched_barrier(0); }
    }
}
__device__ __forceinline__ void qkprep(const Params& P, const bf16_t* QRAW, const bf16_t* KNRAW, const bf16_t* RK, bf16_t* Qf, bf16_t* Kf, char* lds, int c, int G) {
    float* tc = (float*)lds; float* ts = tc + 1024; float* gq = ts + 1024; float* gk = gq + 192;
    const int tid = threadIdx.x, lane = tid & 63, sub = lane & 7;
    __syncthreads();
    for (int i = tid; i < 1024; i += 512) { const int pos = i >> 4, f = i & 15; const float ang = (float)pos * powf(10000.f, -(float)f / 16.f); tc[i] = cosf(ang); ts[i] = sinf(ang); }
    if (tid < 192) { gq[tid] = P.g_qk_q[tid]; gk[tid] = P.g_qk_k[tid]; }
    __syncthreads();
    const int nq = NTOK * NH, ntask = nq + NROW * NH, stride = G * 64;
    for (int tb = c * 64 + (tid >> 3); tb < ntask; tb += 2 * stride) {
        u32x4 v0[2], v1[2], v2[2]; const bf16_t* aP[2]; const bf16_t* rP[2]; int tk[2];
#pragma unroll
        for (int s2 = 0; s2 < 2; ++s2) { int task = tb + s2 * stride; task = task < ntask ? task : tb; tk[s2] = task;
            const bool isq = task < nq; const int it = isq ? task : task - nq, row = it >> 3, h = it & 7;
            aP[s2] = isq ? QRAW + (size_t)row * 1536 + h * 192 : KNRAW + (size_t)row * 1024 + h * 128; rP[s2] = isq ? aP[s2] + 128 : RK + (size_t)row * 64;
            v0[s2] = *(const u32x4*)(aP[s2] + sub * 8); v1[s2] = *(const u32x4*)(aP[s2] + 64 + sub * 8); v2[s2] = *(const u32x4*)(rP[s2] + sub * 8); }
#pragma unroll
        for (int s2 = 0; s2 < 2; ++s2) { if (s2 == 1 && tb + stride >= ntask) break;
            const int task = tk[s2]; const bool isq = task < nq; const int it = isq ? task : task - nq, row = it >> 3, h = it & 7; const float* g = isq ? gq : gk;
            float ss = 0.f;
#pragma unroll
            for (int j = 0; j < 4; ++j) { const float a = bflo(v0[s2][j]), b = bfhi(v0[s2][j]), c2 = bflo(v1[s2][j]), d = bfhi(v1[s2][j]), e = bflo(v2[s2][j]), f = bfhi(v2[s2][j]); ss += (a * a + b * b) + (c2 * c2 + d * d) + (e * e + f * f); }
            ss += __shfl_xor(ss, 1); ss += __shfl_xor(ss, 2); ss += __shfl_xor(ss, 4);
            const float rstd = rsqrtf(ss * (1.f / 192.f) + EPS);
            const bool lat = row < NTOK; int b, pos;
            if (lat) { b = row >> 12; pos = row & 4095; } else { b = (row - NTOK) >> 8; pos = SEQ + ((row - NTOK) & 255); }
            bf16_t* o = isq ? Qf + ((size_t)(b * NH + h) * SEQ + pos) * HQK : Kf + ((size_t)(b * NH + h) * NKEY + pos) * HQK;
            u32x4 w0, w1, w2;
#pragma unroll
            for (int j = 0; j < 4; ++j) { w0[j] = cvtpk(bflo(v0[s2][j]) * rstd * g[sub * 8 + 2 * j], bfhi(v0[s2][j]) * rstd * g[sub * 8 + 2 * j + 1]);
                w1[j] = cvtpk(bflo(v1[s2][j]) * rstd * g[64 + sub * 8 + 2 * j], bfhi(v1[s2][j]) * rstd * g[64 + sub * 8 + 2 * j + 1]); }
            const int ax = sub >> 2, pp = ax ? (pos & 63) : ((pos & 4095) >> 6); const bool second = (sub & 2) != 0;
#pragma unroll
            for (int j = 0; j < 4; ++j) { const unsigned pw = __shfl_xor(v2[s2][j], 2);
                const int e = sub * 8 + 2 * j, ep = (sub ^ 2) * 8 + 2 * j, f = (sub & 1) * 8 + 2 * j;
                const float xoa = bflo(v2[s2][j]) * rstd * g[128 + e], xob = bfhi(v2[s2][j]) * rstd * g[128 + e + 1], xpa = bflo(pw) * rstd * g[128 + ep], xpb = bfhi(pw) * rstd * g[128 + ep + 1];
                float oa = xoa, ob = xob;
                if (lat) { const float ca = tc[pp * 16 + f], sa = ts[pp * 16 + f], cb = tc[pp * 16 + f + 1], sb = ts[pp * 16 + f + 1];
                    oa = second ? xpa * sa + xoa * ca : xoa * ca - xpa * sa; ob = second ? xpb * sb + xob * cb : xob * cb - xpb * sb; }
                w2[j] = cvtpk(oa, ob); }
            *(u32x4*)(o + sub * 8) = w0; *(u32x4*)(o + 64 + sub * 8) = w1; *(u32x4*)(o + 128 + sub * 8) = w2; }
    }
}
__device__ __forceinline__ void mixnorm(const bf16_t* Y, const bf16_t* ATT, bf16_t* MIXA, int c, int G) {
    int tid = threadIdx.x; asm volatile("" : "+v"(tid)); const int lane = tid & 63;
    for (int row = c * 8 + (tid >> 6); row < NTOK; row += G * 8) {
#pragma unroll
        for (int part = 0; part < 2; ++part) { const bf16_t* src = (part ? ATT : Y) + (size_t)row * 1024;
            const u32x4 a = *(const u32x4*)(src + lane * 8), b = *(const u32x4*)(src + 512 + lane * 8); float ss = 0.f;
#pragma unroll
            for (int j = 0; j < 4; ++j) { const float a0 = bflo(a[j]), a1 = bfhi(a[j]), b0 = bflo(b[j]), b1 = bfhi(b[j]); ss += (a0 * a0 + a1 * a1) + (b0 * b0 + b1 * b1); }
            const float rs = rsqrtf(wave_sum(ss) * (1.f / 1024.f) + EPS); u32x4 oa, ob;
#pragma unroll
            for (int j = 0; j < 4; ++j) { oa[j] = cvtpk(bflo(a[j]) * rs, bfhi(a[j]) * rs); ob[j] = cvtpk(bflo(b[j]) * rs, bfhi(b[j]) * rs); }
            bf16_t* dst = MIXA + (size_t)row * 2048 + part * 1024; *(u32x4*)(dst + lane * 8) = oa; *(u32x4*)(dst + 512 + lane * 8) = ob; }
    }
}
__device__ __forceinline__ void route_consts(const Params& P, const float* mod, const float* WR, float* AB, float* SHW, int c, int G) {
    const int tid = threadIdx.x, lane = tid & 63;
    for (int i = c * 512 + tid; i < 2 * 2048; i += G * 512) { const int b = i >> 11, k = i & 2047; AB[i] = P.g2[k] * (1.f + mod[b * NMOD + 4 * D + k]); }
    for (int task = c * 8 + (tid >> 6); task < 2 * 96; task += G * 8) { const int b = task / 96, o = task % 96; const float* sh = mod + b * NMOD + 3 * D; float s = 0.f;
        for (int k = lane; k < 2048; k += 64) s += sh[k] * WR[(size_t)k * 96 + o];
        s = wave_sum(s); if (lane == 0) SHW[task] = s; }
}
constexpr int RT_PART = 0, RT_SSQ = 8 * 32 * 81 * 4, RT_RS = RT_SSQ + 8 * 32 * 4, RT_LG = RT_RS + 128, RT_BYTES = RT_LG + 32 * 81 * 4;
__device__ __forceinline__ void route(const Params& P, const float* mod, const float* AB, const float* SHW, const bf16_t* WRH, const bf16_t* WRL, bf16_t* HM, int* cnt, int* toke, int* tokp, int* sltok, float* slw, char* lds, int c, int G) {
    using bf16x8 = __attribute__((ext_vector_type(8))) short;
    const int tid = threadIdx.x, wid = __builtin_amdgcn_readfirstlane(tid >> 6), lane = tid & 63, l16 = lane & 15, fq = lane >> 4;
    float* part = (float*)(lds + RT_PART); float* ssqp = (float*)(lds + RT_SSQ); float* rs = (float*)(lds + RT_RS); float* lg = (float*)(lds + RT_LG);
    for (int u = c; u < NTOK / 32; u += G) {
        const int t0 = u * 32, b = t0 >> 12;
        const float* ab = AB + b * 2048; const float* sh = mod + b * NMOD + 3 * D;
        f32x4 acc[2][5];
#pragma unroll
        for (int tt = 0; tt < 2; ++tt)
#pragma unroll
            for (int ot = 0; ot < 5; ++ot) acc[tt][ot] = (f32x4){0.f, 0.f, 0.f, 0.f};
        float ssq0 = 0.f, ssq1 = 0.f;
        __syncthreads();
        f32x4 xa[4], ca[2]; u32x4 wa[10];
#define RT_LOAD(X, C, W, ks_) do { const int k0_ = wid * 256 + (ks_) * 32 + 8 * fq; C[0] = *(const f32x4*)(ab + k0_); C[1] = *(const f32x4*)(ab + k0_ + 4); \
            _Pragma("unroll") for (int tt = 0; tt < 2; ++tt) { const float* xp = P.out + (size_t)(t0 + tt * 16 + l16) * D + k0_; X[tt * 2] = *(const f32x4*)xp; X[tt * 2 + 1] = *(const f32x4*)(xp + 4); } \
            _Pragma("unroll") for (int ot = 0; ot < 5; ++ot) { W[ot * 2] = *(const u32x4*)(WRH + (size_t)(ot * 16 + l16) * 2048 + k0_); W[ot * 2 + 1] = *(const u32x4*)(WRL + (size_t)(ot * 16 + l16) * 2048 + k0_); } } while (0)
#define RT_COMP(X, C, W) do { bf16x8 ah[2], al[2]; \
            _Pragma("unroll") for (int tt = 0; tt < 2; ++tt) { const f32x4 x0 = X[tt * 2], x1 = X[tt * 2 + 1]; \
                const float q = (x0[0] * x0[0] + x0[1] * x0[1]) + (x0[2] * x0[2] + x0[3] * x0[3]) + (x1[0] * x1[0] + x1[1] * x1[1]) + (x1[2] * x1[2] + x1[3] * x1[3]); \
                if (tt == 0) ssq0 += q; else ssq1 += q; \
                const f32x4 v0 = x0 * C[0], v1 = x1 * C[1]; u32x4 hb, lb; \
                hb[0] = cvtpk(v0[0], v0[1]); hb[1] = cvtpk(v0[2], v0[3]); hb[2] = cvtpk(v1[0], v1[1]); hb[3] = cvtpk(v1[2], v1[3]); \
                lb[0] = cvtpk(v0[0] - bflo(hb[0]), v0[1] - bfhi(hb[0])); lb[1] = cvtpk(v0[2] - bflo(hb[1]), v0[3] - bfhi(hb[1])); \
                lb[2] = cvtpk(v1[0] - bflo(hb[2]), v1[1] - bfhi(hb[2])); lb[3] = cvtpk(v1[2] - bflo(hb[3]), v1[3] - bfhi(hb[3])); \
                ah[tt] = *reinterpret_cast<bf16x8*>(&hb); al[tt] = *reinterpret_cast<bf16x8*>(&lb); } \
            _Pragma("unroll") for (int ot = 0; ot < 5; ++ot) { const bf16x8 bh = *reinterpret_cast<const bf16x8*>(&W[ot * 2]), bl = *reinterpret_cast<const bf16x8*>(&W[ot * 2 + 1]); \
                _Pragma("unroll") for (int tt = 0; tt < 2; ++tt) { acc[tt][ot] = __builtin_amdgcn_mfma_f32_16x16x32_bf16(ah[tt], bh, acc[tt][ot], 0, 0, 0); \
                    acc[tt][ot] = __builtin_amdgcn_mfma_f32_16x16x32_bf16(ah[tt], bl, acc[tt][ot], 0, 0, 0); acc[tt][ot] = __builtin_amdgcn_mfma_f32_16x16x32_bf16(al[tt], bh, acc[tt][ot], 0, 0, 0); } } } while (0)
#pragma unroll 1
        for (int ks = 0; ks < 8; ++ks) {
            RT_LOAD(xa, ca, wa, ks); __builtin_amdgcn_sched_barrier(0);
            RT_COMP(xa, ca, wa); __builtin_amdgcn_sched_barrier(0);
        }
#undef RT_LOAD
#undef RT_COMP
#pragma unroll
        for (int tt = 0; tt < 2; ++tt)
#pragma unroll
            for (int ot = 0; ot < 5; ++ot)
#pragma unroll
                for (int r = 0; r < 4; ++r) part[(wid * 32 + tt * 16 + 4 * fq + r) * 81 + ot * 16 + l16] = acc[tt][ot][r];
        ssq0 += __shfl_xor(ssq0, 16); ssq0 += __shfl_xor(ssq0, 32); ssq1 += __shfl_xor(ssq1, 16); ssq1 += __shfl_xor(ssq1, 32);
        if (fq == 0) { ssqp[wid * 32 + l16] = ssq0; ssqp[wid * 32 + 16 + l16] = ssq1; }
        __syncthreads();
        if (tid < 32) { float q = 0.f;
#pragma unroll
            for (int w = 0; w < 8; ++w) q += ssqp[w * 32 + tid];
            rs[tid] = rsqrtf(q * (1.f / 2048.f) + EPS); }
        __syncthreads();
        for (int i = tid; i < 32 * 72; i += 512) { const int tk = i / 72, o = i - tk * 72; float q = 0.f;
#pragma unroll
            for (int w = 0; w < 8; ++w) q += part[(w * 32 + tk) * 81 + o];
            lg[tk * 81 + o] = q * rs[tk] + SHW[b * 96 + o] + (o < 8 ? P.b_rg[o] : P.b_re[o - 8]); }
        __syncthreads();
        if (tid < 32) { const float* l = lg + tid * 81; const int t = t0 + tid;
            int gi = 0; float gm = l[0]; for (int j = 1; j < 8; ++j) if (l[j] > gm) { gm = l[j]; gi = j; }
            float gsum = 0.f; for (int j = 0; j < 8; ++j) gsum += expf(l[j] - gm); const float gp = 1.f / gsum;
            const float* el = l + 8 + gi * 8;
            int i0 = 0; float m0 = el[0]; for (int j = 1; j < 8; ++j) if (el[j] > m0) { m0 = el[j]; i0 = j; }
            int i1 = -1; float m1 = -1e30f; for (int j = 0; j < 8; ++j) if (j != i0 && el[j] > m1) { m1 = el[j]; i1 = j; }
            const float rr = expf(m1 - m0), p0 = 1.f / (1.f + rr), p1 = rr / (1.f + rr);
            const int e0 = gi * 8 + i0, e1 = gi * 8 + i1;
            const int q0 = atomicAdd(&cnt[e0 * 64], 1), q1 = atomicAdd(&cnt[e1 * 64], 1);
            toke[t * 2] = e0; toke[t * 2 + 1] = e1; tokp[t * 2] = q0; tokp[t * 2 + 1] = q1;
            sltok[e0 * ECAP + q0] = t; sltok[e1 * ECAP + q1] = t; slw[e0 * ECAP + q0] = gp * p0; slw[e1 * ECAP + q1] = gp * p1; }
        { int laneH = lane; asm volatile("" : "+v"(laneH));
          unsigned char* HM8 = (unsigned char*)HM;
          f32x4 av[8], sv[8];
#pragma unroll
          for (int it = 0; it < 2; ++it)
#pragma unroll
              for (int j = 0; j < 4; ++j) { const int col = it * 1024 + laneH * 16 + 4 * j; av[it * 4 + j] = *(const f32x4*)(ab + col); sv[it * 4 + j] = *(const f32x4*)(sh + col); }
#pragma unroll
          for (int q2 = 0; q2 < 2; ++q2) { f32x4 xv[2][8];
#pragma unroll
            for (int qq = 0; qq < 2; ++qq) { const float* src = P.out + (size_t)(t0 + wid * 4 + q2 * 2 + qq) * D;
#pragma unroll
                for (int it = 0; it < 2; ++it)
#pragma unroll
                    for (int j = 0; j < 4; ++j) xv[qq][it * 4 + j] = *(const f32x4*)(src + it * 1024 + laneH * 16 + 4 * j); }
            __builtin_amdgcn_sched_barrier(0);
#pragma unroll
            for (int qq = 0; qq < 2; ++qq) { const int tk = wid * 4 + q2 * 2 + qq; const float rstd = rs[tk]; unsigned char* dst = HM8 + (size_t)(t0 + tk) * HMLD;
#pragma unroll
                for (int it = 0; it < 2; ++it) { u32x4 w;
#pragma unroll
                    for (int j = 0; j < 4; ++j) { const f32x4 o = xv[qq][it * 4 + j] * rstd * av[it * 4 + j] + sv[it * 4 + j];
                        int p_ = __builtin_amdgcn_cvt_pk_fp8_f32(o[0], o[1], 0, false); p_ = __builtin_amdgcn_cvt_pk_fp8_f32(o[2], o[3], p_, true); w[j] = (unsigned)p_; }
                    *(u32x4*)(dst + it * 1024 + laneH * 16) = w; } }
            __builtin_amdgcn_sched_barrier(0); } }
    }
}
__device__ __forceinline__ void combine(float* out, float* dst, const float* mod, const bf16_t* YS, const int* cnt, const int* toke, const int* tokp, char* lds, int c, int G) {
    int* base = (int*)lds; int tid = threadIdx.x; asm volatile("" : "+v"(tid)); const int lane = tid & 63;
    __syncthreads();
    if (tid < 64) { int s = 0; for (int i = 0; i < tid; ++i) s += cnt[i * 64]; base[tid] = s; }
    __syncthreads();
    for (int t = c * 8 + (tid >> 6); t < NTOK; t += G * 8) {
        const int2 te = *(const int2*)(toke + t * 2), tp = *(const int2*)(tokp + t * 2);
        const int s0 = base[te.x] + tp.x, s1 = base[te.y] + tp.y;
        const float* gt = mod + (t >> 12) * NMOD + 5 * D;
        u32x4 a[4], b2[4]; f32x4 o0[4], o1[4], g0[4], g1[4];
#pragma unroll
        for (int it = 0; it < 4; ++it) { const int col = it * 512 + lane * 8; const float* op = out + (size_t)t * D + col;
            a[it] = *(const u32x4*)(YS + (size_t)s0 * D + col); b2[it] = *(const u32x4*)(YS + (size_t)s1 * D + col);
            o0[it] = *(const f32x4*)op; o1[it] = *(const f32x4*)(op + 4); g0[it] = *(const f32x4*)(gt + col); g1[it] = *(const f32x4*)(gt + col + 4); }
#pragma unroll
        for (int it = 0; it < 4; ++it) { const int col = it * 512 + lane * 8; float* op = dst + (size_t)t * D + col;
            f32x4 p0 = o0[it], p1 = o1[it];
            p0[0] += g0[it][0] * (bflo(a[it][0]) + bflo(b2[it][0])); p0[1] += g0[it][1] * (bfhi(a[it][0]) + bfhi(b2[it][0])); p0[2] += g0[it][2] * (bflo(a[it][1]) + bflo(b2[it][1])); p0[3] += g0[it][3] * (bfhi(a[it][1]) + bfhi(b2[it][1]));
            p1[0] += g1[it][0] * (bflo(a[it][2]) + bflo(b2[it][2])); p1[1] += g1[it][1] * (bfhi(a[it][2]) + bfhi(b2[it][2])); p1[2] += g1[it][2] * (bflo(a[it][3]) + bflo(b2[it][3])); p1[3] += g1[it][3] * (bfhi(a[it][3]) + bfhi(b2[it][3]));
            *(f32x4*)op = p0; *(f32x4*)(op + 4) = p1; }
    }
}


template <int NS, int SEG>
__device__ __forceinline__ void bstream_probe(const float* wg, const float* wu, char* lds, int c) {
    using u32x4 = __attribute__((ext_vector_type(4))) unsigned;
    const int tid = threadIdx.x, wid = __builtin_amdgcn_readfirstlane(tid >> 6), half = wid >> 2, tq = tid & 255, ng = tq & 15, kq = tq >> 4;
    unsigned sink = 0;
    for (int idx = c >> 3; idx < 96; idx += 32) { const int e = (c & 7) + 8 * (idx / 12), j = idx % 12;
        const float* W = SEG == 0 ? (half ? wu : wg) + (size_t)e * 2048 * 768 + j * 64 : ((j & 1) ? wu : wg) + (size_t)e * 2048 * 768 + (j >> 1) * 128 + half * 64;
        const __amdgpu_buffer_rsrc_t rs = __builtin_amdgcn_make_buffer_rsrc((void*)W, (short)0, 2048 * 768 * 4, 0x00020000);
        const unsigned boff = (unsigned)((4 * kq) * 768 + 4 * ng) * 4u;
        u32x4 st[NS][4];
#pragma unroll
        for (int s2 = 0; s2 < NS; ++s2)
#pragma unroll
            for (int jj = 0; jj < 4; ++jj) st[s2][jj] = __builtin_amdgcn_raw_buffer_load_b128(rs, boff, (s2 * 64 + jj) * 3072, 0);
        for (int t = 0; t < 32; t += NS) {
#pragma unroll
            for (int s2 = 0; s2 < NS; ++s2) { unsigned acc = 0;
#pragma unroll
                for (int jj = 0; jj < 4; ++jj) acc ^= st[s2][jj][0] ^ st[s2][jj][1] ^ st[s2][jj][2] ^ st[s2][jj][3];
                *(unsigned*)(lds + ((t + s2) & 1) * 8192 + tid * 4) = acc; sink ^= acc;
                const int kn = ((t + s2 + NS) & 31) * 64;
#pragma unroll
                for (int jj = 0; jj < 4; ++jj) st[s2][jj] = __builtin_amdgcn_raw_buffer_load_b128(rs, boff, (kn + jj) * 3072, 0);
                __syncthreads(); }
        }
        asm volatile("s_waitcnt vmcnt(0)" ::: "memory");
    }
    if (sink == 0x12345u) *(unsigned*)(lds) = sink;
}
template <int LO, int HI>
__global__ __launch_bounds__(512, 2) void mk_fwd(Params P) {
    extern __shared__ __attribute__((aligned(16))) unsigned char shm[];
    char* lds = (char*)shm + LDS_PH; char* ws = P.ws;
    const int c = (int)blockIdx.x, G = (int)gridDim.x;
    unsigned* bar = (unsigned*)(ws + WS_CTL); int* CNT = (int*)(ws + WS_CTL) + 4096; float* MOD = (float*)(ws + WS_MOD);
    bf16_t* WinT = (bf16_t*)(ws + WS_WINT); bf16_t* WuqT = (bf16_t*)(ws + WS_WUQT); bf16_t* WukvT = (bf16_t*)(ws + WS_WUKVT); bf16_t* WoutT = (bf16_t*)(ws + WS_WOUTT);
    bf16_t* HX = (bf16_t*)(ws + WS_HX); bf16_t* Gb = (bf16_t*)(ws + WS_G); bf16_t* QLb = (bf16_t*)(ws + WS_QL); bf16_t* KVLb = (bf16_t*)(ws + WS_KVL); bf16_t* RK = (bf16_t*)(ws + WS_ROPEK);
    bf16_t* QRAW = (bf16_t*)(ws + WS_QRAW); bf16_t* KNRAW = (bf16_t*)(ws + WS_KNRAW); bf16_t* Vf = (bf16_t*)(ws + WS_VF); bf16_t* Qf = (bf16_t*)(ws + WS_QF); bf16_t* Kf = (bf16_t*)(ws + WS_KF);
    bf16_t* ATT = (bf16_t*)(ws + WS_ATT); bf16_t* T1 = (bf16_t*)(ws + WS_T1); bf16_t* Y = (bf16_t*)(ws + WS_Y); bf16_t* MIXA = (bf16_t*)(ws + WS_MIXA); bf16_t* HM = (bf16_t*)(ws + WS_HM);
    int* TOKE = (int*)(ws + WS_TOKE); int* TOKP = (int*)(ws + WS_TOKP); int* SLTOK = (int*)(ws + WS_SLTOK); float* SLW = (float*)(ws + WS_SLW);
    bf16_t* H = (bf16_t*)(ws + WS_H); bf16_t* YS = (bf16_t*)(ws + WS_YS); float* SSQP = (float*)(ws + WS_SSQP);
    bf16_t* WF = (bf16_t*)(ws + WS_WF); bf16_t* MT = (bf16_t*)(ws + WS_MT); float* WR = (float*)(ws + WS_WR);
    XcdBarrier xb;
    if constexpr (HI - LO > 1) {
        if (threadIdx.x == 0) *(uint4*)(shm + LDS_XB) = make_uint4(0u, 0u, 0u, 0u);
        __syncthreads();
        xb = xcd_barrier_post(bar, (volatile LAS unsigned*)(shm + LDS_XB));
    }
#define MK_PHASE(p) if constexpr (LO <= (p) && (p) < HI)
#define MK_SEAM(p) if constexpr (LO <= (p) && (p) + 1 < HI) xcd_barrier(xb)
    MK_PHASE(0) { for (int u = c; u < 192; u += G) ada_unit(P, MOD, u, lds); p0_jobs(P, lds, c, G); }
    MK_SEAM(0);
    MK_PHASE(1) {
        if (c < 64) { pg8::OrdOne S; S.pm = (c & 15) >> 3; S.pn = c & 7; const int g = c >> 4;
            pg8::gemm_phase<pg8::EpiFold, pg8::OrdOne, false>((PG8_LAS unsigned char*)lds, pg8::Gemm{MT, WF + g * 256, 512, 2048, 256, 256, 1024, 0}, S, pg8::EpiFold{WinT, g, 0}, nullptr); }
        if (G == 256) { if (c < 64) hx_rows(P, MOD, HX, c, 448); else { hx_rows(P, MOD, HX, 64 + 2 * (c - 64), 448); hx_rows(P, MOD, HX, 65 + 2 * (c - 64), 448); } }
        else hx_rows(P, MOD, HX, c, G); }
    MK_SEAM(1);
    MK_PHASE(2) { pg8::OrdInproj S; S.G = G; S.c = c; pg8::gemm_phase<pg8::EpiInproj, pg8::OrdInproj, false>((PG8_LAS unsigned char*)lds, pg8::Gemm{HX, WinT, NROW, WIN_ROWS, D, D, D, 0}, S, pg8::EpiInproj{Gb, QLb, KVLb, RK, SSQP}, nullptr);
        if (G == 256) { if (c >= 198) tcvt_tiles(P, ws, lds, 1216 + (c - 198), 58, 2240); } else tcvt_tiles(P, ws, lds, 1216 + c, G, 2240); }
    MK_SEAM(2);
    MK_PHASE(3) {
        { pg8::OrdGrid S; S.nM = 32; S.nN = 6; S.G = G; S.c = c; if (c < 192) pg8::gemm_phase<pg8::EpiQ, pg8::OrdGrid, false>((PG8_LAS unsigned char*)lds, pg8::Gemm{QLb, WuqT, NTOK, 1536, 768, 768, 768, 0}, S, pg8::EpiQ{QRAW, SSQP}, nullptr); }
        __syncthreads();
        { pg8::OrdKV S; S.c = c; pg8::gemm_phase<pg8::EpiKV, pg8::OrdKV, false>((PG8_LAS unsigned char*)lds, pg8::Gemm{KVLb, WukvT, NROW, 2048, 512, 512, 512, 0}, S, pg8::EpiKV{KNRAW, Vf, SSQP}, nullptr); } }
    MK_SEAM(3);
    MK_PHASE(4) { qkprep(P, QRAW, KNRAW, RK, Qf, Kf, lds, c, G); dft::phase<1>(Gb, T1, lds, c, G); }
    MK_SEAM(4);
    MK_PHASE(5) { dft::phase<2>(T1, Y, lds, c, G); __syncthreads(); attn_phase(Qf, Kf, Vf, ATT, lds, c, G, P.w_gate, P.w_up, (unsigned char*)(ws + WS_SC) + (64u << 20)); }
    MK_SEAM(5);
    MK_PHASE(6) { mixnorm(Y, ATT, MIXA, c, G); route_consts(P, MOD, WR, (float*)(ws + WS_AB), (float*)(ws + WS_SHW), c, G); }
    MK_SEAM(6);
    MK_PHASE(7) { pg8::OrdGrid S; S.nM = 32; S.nN = 8; S.G = G; S.c = c; pg8::gemm_phase<pg8::EpiOut, pg8::OrdGrid, false>((PG8_LAS unsigned char*)lds, pg8::Gemm{MIXA, WoutT, NTOK, D, 2048, 2048, 2048, 0}, S, pg8::EpiOut{P.out, P.x, MOD}, nullptr); }
    MK_SEAM(7);
    MK_PHASE(8) { route(P, MOD, (const float*)(ws + WS_AB), (const float*)(ws + WS_SHW), (const bf16_t*)(ws + WS_WRH), (const bf16_t*)(ws + WS_WRL), HM, CNT, TOKE, TOKP, SLTOK, SLW, lds, c, G); }
    MK_SEAM(8);
    MK_PHASE(9) { moe::moe_phase<0>((const unsigned char*)HM, SLTOK, nullptr, P.w_gate, P.w_up, (void*)H, CNT, lds, c, G, (unsigned char*)(ws + WS_SC) + (256u << 20), (unsigned*)(ws + WS_CTL) + 10240 + 256 * 0, (const unsigned char*)(ws + WS_SC) + (64u << 20)); }
    MK_SEAM(9);
    MK_PHASE(10) { moe::moe_phase<1>((const unsigned char*)H, nullptr, SLW, P.w_down, nullptr, (void*)YS, CNT, lds, c, G, (unsigned char*)(ws + WS_SC) + (256u << 20), (unsigned*)(ws + WS_CTL) + 10240 + 256 * 1); }
    MK_SEAM(10);
    MK_PHASE(11) { combine(P.out, P.out, MOD, YS, CNT, TOKE, TOKP, lds, c, G); }
    MK_PHASE(12) { qkprep(P, QRAW, KNRAW, RK, Qf, Kf, lds, c, G); }
    MK_PHASE(13) { dft::phase<1>(Gb, T1, lds, c, G); }
    MK_PHASE(14) { dft::phase<2>(T1, Y, lds, c, G); }
    MK_PHASE(15) { attn_phase(Qf, Kf, Vf, ATT, lds, c, G, P.w_gate, P.w_up, (unsigned char*)(ws + WS_SC) + (64u << 20)); }
    MK_PHASE(16) { hx_rows(P, MOD, HX, c, G); }
    MK_PHASE(17) { for (int u = c; u < 192; u += G) ada_unit(P, MOD, u, lds); }
    MK_PHASE(20) { moe::moe_phase<0, 1>((const unsigned char*)HM, SLTOK, nullptr, P.w_gate, P.w_up, (void*)H, CNT, lds, c, G, (unsigned char*)(ws + WS_SC) + (256u << 20), (unsigned*)(ws + WS_CTL) + 10240 + 256 * 2); }
    MK_PHASE(21) { moe::moe_phase<0, 2>((const unsigned char*)HM, SLTOK, nullptr, P.w_gate, P.w_up, (void*)H, CNT, lds, c, G, (unsigned char*)(ws + WS_SC) + (256u << 20), (unsigned*)(ws + WS_CTL) + 10240 + 256 * 2); }
    MK_PHASE(22) { moe::moe_phase<0, 3>((const unsigned char*)HM, SLTOK, nullptr, P.w_gate, P.w_up, (void*)H, CNT, lds, c, G, (unsigned char*)(ws + WS_SC) + (256u << 20), (unsigned*)(ws + WS_CTL) + 10240 + 256 * 2); }
    MK_PHASE(23) { moe::moe_phase<0, 4>((const unsigned char*)HM, SLTOK, nullptr, P.w_gate, P.w_up, (void*)H, CNT, lds, c, G, (unsigned char*)(ws + WS_SC) + (256u << 20), (unsigned*)(ws + WS_CTL) + 10240 + 256 * 2); }
    MK_PHASE(25) { bstream_probe<2, 0>(P.w_gate, P.w_up, lds, c); }
    MK_PHASE(26) { bstream_probe<4, 0>(P.w_gate, P.w_up, lds, c); }
    MK_PHASE(27) { bstream_probe<8, 0>(P.w_gate, P.w_up, lds, c); }
    MK_PHASE(28) { bstream_probe<4, 1>(P.w_gate, P.w_up, lds, c); }
    MK_PHASE(24) { moe::moe_phase<0, 8>((const unsigned char*)HM, SLTOK, nullptr, P.w_gate, P.w_up, (void*)H, CNT, lds, c, G, (unsigned char*)(ws + WS_SC) + (256u << 20), (unsigned*)(ws + WS_CTL) + 10240 + 256 * 2, (const unsigned char*)(ws + WS_SC) + (64u << 20)); }
    MK_PHASE(29) { moe::moe_phase<0, 24>((const unsigned char*)HM, SLTOK, nullptr, P.w_gate, P.w_up, (void*)H, CNT, lds, c, G, (unsigned char*)(ws + WS_SC) + (256u << 20), (unsigned*)(ws + WS_CTL) + 10240 + 256 * 2, (const unsigned char*)(ws + WS_SC) + (64u << 20)); }
    MK_PHASE(32) { moe::moe_phase<0, 8|2>((const unsigned char*)HM, SLTOK, nullptr, P.w_gate, P.w_up, (void*)H, CNT, lds, c, G, (unsigned char*)(ws + WS_SC) + (256u << 20), (unsigned*)(ws + WS_CTL) + 10240 + 256 * 2, (const unsigned char*)(ws + WS_SC) + (64u << 20)); }
    MK_PHASE(33) { moe::moe_phase<0, 8|1|2>((const unsigned char*)HM, SLTOK, nullptr, P.w_gate, P.w_up, (void*)H, CNT, lds, c, G, (unsigned char*)(ws + WS_SC) + (256u << 20), (unsigned*)(ws + WS_CTL) + 10240 + 256 * 2, (const unsigned char*)(ws + WS_SC) + (64u << 20)); }
    MK_PHASE(34) { moe::moe_phase<0, 8|4>((const unsigned char*)HM, SLTOK, nullptr, P.w_gate, P.w_up, (void*)H, CNT, lds, c, G, (unsigned char*)(ws + WS_SC) + (256u << 20), (unsigned*)(ws + WS_CTL) + 10240 + 256 * 2, (const unsigned char*)(ws + WS_SC) + (64u << 20)); }
    MK_PHASE(35) { moe::moe_phase<0, 8|1|4>((const unsigned char*)HM, SLTOK, nullptr, P.w_gate, P.w_up, (void*)H, CNT, lds, c, G, (unsigned char*)(ws + WS_SC) + (256u << 20), (unsigned*)(ws + WS_CTL) + 10240 + 256 * 2, (const unsigned char*)(ws + WS_SC) + (64u << 20)); }
    MK_PHASE(36) { moe::moe_phase<0, 8|1|4>((const unsigned char*)HM, SLTOK, nullptr, P.w_gate, P.w_up, (void*)H, CNT, lds, c, G, (unsigned char*)(ws + WS_SC) + (256u << 20), (unsigned*)(ws + WS_CTL) + 10240 + 256 * 2, nullptr); }
    MK_PHASE(37) { moe::moe_phase<0, 8|1|4|32>((const unsigned char*)HM, SLTOK, nullptr, P.w_gate, P.w_up, (void*)H, CNT, lds, c, G, (unsigned char*)(ws + WS_SC) + (256u << 20), (unsigned*)(ws + WS_CTL) + 10240 + 256 * 2, (const unsigned char*)(ws + WS_SC) + (64u << 20)); }
    MK_PHASE(38) { moe::moe_phase<0, 8|1|4|64>((const unsigned char*)HM, SLTOK, nullptr, P.w_gate, P.w_up, (void*)H, CNT, lds, c, G, (unsigned char*)(ws + WS_SC) + (256u << 20), (unsigned*)(ws + WS_CTL) + 10240 + 256 * 2, (const unsigned char*)(ws + WS_SC) + (64u << 20)); }
#define MK_STATWAIT(expr_us) if (c == 0 && threadIdx.x == 0) { int mx = 0, mn = 1 << 30, n384 = 0, n256 = 0, n272 = 0, n320 = 0; for (int e = 0; e < 64; ++e) { const int v = CNT[e * 64]; mx = v > mx ? v : mx; mn = v < mn ? v : mn; n384 += v > 384; n256 += v > 256; n272 += v > 272; n320 += v > 320; } \
        const long long t0 = wall_clock64(); const long long wt = (long long)(expr_us) * 100; while (wall_clock64() - t0 < wt) __builtin_amdgcn_s_sleep(8); }
    MK_PHASE(41) { MK_STATWAIT(mx); }
    MK_PHASE(42) { MK_STATWAIT(n384 * 20); }
    MK_PHASE(43) { MK_STATWAIT(n256 * 10); }
    MK_PHASE(44) { MK_STATWAIT(mn); }
    MK_PHASE(45) { MK_STATWAIT(n320 * 10); }
    MK_PHASE(39) { moe::moe_phase<0, 8|1|4|64|128>((const unsigned char*)HM, SLTOK, nullptr, P.w_gate, P.w_up, (void*)H, CNT, lds, c, G, (unsigned char*)(ws + WS_SC) + (256u << 20), (unsigned*)(ws + WS_CTL) + 10240 + 256 * 2, (const unsigned char*)(ws + WS_SC) + (64u << 20)); }
    MK_PHASE(46) { moe::moe_phase<0, 8|128>((const unsigned char*)HM, SLTOK, nullptr, P.w_gate, P.w_up, (void*)H, CNT, lds, c, G, (unsigned char*)(ws + WS_SC) + (256u << 20), (unsigned*)(ws + WS_CTL) + 10240 + 256 * 2, (const unsigned char*)(ws + WS_SC) + (64u << 20)); }
    MK_PHASE(47) { moe::moe_phase<1, 8|128>((const unsigned char*)H, nullptr, SLW, P.w_down, nullptr, (void*)YS, CNT, lds, c, G, (unsigned char*)(ws + WS_SC) + (256u << 20), (unsigned*)(ws + WS_CTL) + 10240 + 256 * 2); }
    MK_PHASE(30) { moe::moe_phase<1, 8>((const unsigned char*)H, nullptr, SLW, P.w_down, nullptr, (void*)YS, CNT, lds, c, G, (unsigned char*)(ws + WS_SC) + (256u << 20), (unsigned*)(ws + WS_CTL) + 10240 + 256 * 2); }
    MK_PHASE(31) { moe::moe_phase<1, 24>((const unsigned char*)H, nullptr, SLW, P.w_down, nullptr, (void*)YS, CNT, lds, c, G, (unsigned char*)(ws + WS_SC) + (256u << 20), (unsigned*)(ws + WS_CTL) + 10240 + 256 * 2); }
    MK_PHASE(18) { char* sc = ws + WS_SC; route(P, MOD, (const float*)(ws + WS_AB), (const float*)(ws + WS_SHW), (const bf16_t*)(ws + WS_WRH), (const bf16_t*)(ws + WS_WRL), (bf16_t*)(sc + (64u << 20)), (int*)sc, (int*)(sc + (1u << 20)), (int*)(sc + (2u << 20)), (int*)(sc + (4u << 20)), (float*)(sc + (8u << 20)), lds, c, G); }
    MK_PHASE(19) { combine(P.out, (float*)(ws + WS_SC), MOD, YS, CNT, TOKE, TOKP, lds, c, G); }
#undef MK_PHASE
#undef MK_SEAM
}
}
}

#ifndef MK_MODE
#define MK_MODE 2
#endif
template <int LO, int HI> static bool mk_launch(const mk::Params& P, int grid, hipStream_t stream) {
    static int ok = 0;
    if (!ok) { if (hipFuncSetAttribute((const void*)mk::mk_fwd<LO, HI>, hipFuncAttributeMaxDynamicSharedMemorySize, mk::LDS_TOTAL) != hipSuccess) { fprintf(stderr, "kernel_launch: hipFuncSetAttribute failed\n"); return false; } ok = 1; }
    hipLaunchKernelGGL((mk::mk_fwd<LO, HI>), dim3(grid), dim3(512), mk::LDS_TOTAL, stream, P);
    const hipError_t e = hipPeekAtLastError(); if (e != hipSuccess) { fprintf(stderr, "kernel_launch: launch [%d,%d) failed: %s\n", LO, HI, hipGetErrorName(e)); return false; }
    return true;
}
extern "C" void kernel_launch(void* const* d_in, const int* in_sizes, int n_in, void* d_out, int out_size, void* d_ws, size_t ws_size, hipStream_t stream) {
    if (n_in != 25 || out_size != NTOK * D || ws_size < WS_END) { fprintf(stderr, "kernel_launch: unexpected shapes (n_in %d out %d ws %zu need %zu)\n", n_in, out_size, ws_size, (size_t)WS_END); return; }
    mk::Params P{};
    const float** pf = (const float**)&P;
    for (int i = 0; i < 25; ++i) pf[i] = (const float*)d_in[i];
    P.out = (float*)d_out; P.ws = (char*)d_ws;
    static int grid = 0;
    if (!grid) { int dev = 0, cus = 0; if (hipGetDevice(&dev) != hipSuccess || hipDeviceGetAttribute(&cus, hipDeviceAttributeMultiprocessorCount, dev) != hipSuccess || cus < 1) { fprintf(stderr, "kernel_launch: device query failed\n"); return; }
        grid = cus; }
    if (hipMemsetAsync((char*)d_ws + WS_CTL, 0, 65536, stream) != hipSuccess) { fprintf(stderr, "kernel_launch: memset failed\n"); return; }
#if MK_MODE == 2
    mk_launch<0, 12>(P, grid, stream);
#ifdef MK_PROBE_EXTRA
    MK_PROBE_EXTRA
#endif
#else
    mk_launch<0, 1>(P, grid, stream) && mk_launch<1, 2>(P, grid, stream) && mk_launch<2, 3>(P, grid, stream) && mk_launch<3, 4>(P, grid, stream) && mk_launch<4, 5>(P, grid, stream) && mk_launch<5, 6>(P, grid, stream) &&
    mk_launch<6, 7>(P, grid, stream) && mk_launch<7, 8>(P, grid, stream) && mk_launch<8, 9>(P, grid, stream) && mk_launch<9, 10>(P, grid, stream) && mk_launch<10, 11>(P, grid, stream) && mk_launch<11, 12>(P, grid, stream);
#endif
}
#if 0
extern "C" void kernel_launch(void* const* d_in, const int* in_sizes, int n_in, void* d_out, int out_size, void* d_ws, size_t ws_size, hipStream_t stream) {
    if (n_in != 25 || out_size != NTOK * D || ws_size < WS_END) { fprintf(stderr, "kernel_launch: unexpected shapes (n_in %d out %d ws %zu need %zu)\n", n_in, out_size, ws_size, (size_t)WS_END); return; }
    const float* x = (const float*)d_in[0]; const float* c = (const float*)d_in[1]; const float* ctx = (const float*)d_in[2]; const float* cctx = (const float*)d_in[3];
    const float* w_ada = (const float*)d_in[4]; const float* b_ada = (const float*)d_in[5]; const float* g1 = (const float*)d_in[6]; const float* g2 = (const float*)d_in[7];
    const float* w_in = (const float*)d_in[8]; const float* g_q_a = (const float*)d_in[9]; const float* g_kv_a = (const float*)d_in[10]; const float* w_uq = (const float*)d_in[11];
    const float* w_ukv = (const float*)d_in[12]; const float* g_qk_q = (const float*)d_in[13]; const float* g_qk_k = (const float*)d_in[14]; const float* g_of = (const float*)d_in[15];
    const float* g_oa = (const float*)d_in[16]; const float* w_out = (const float*)d_in[17]; const float* w_rg = (const float*)d_in[18]; const float* b_rg = (const float*)d_in[19];
    const float* w_re = (const float*)d_in[20]; const float* b_re = (const float*)d_in[21]; const float* w_gate = (const float*)d_in[22]; const float* w_up = (const float*)d_in[23];
    const float* w_down = (const float*)d_in[24];
    float* out = (float*)d_out; char* ws = (char*)d_ws;
    int* CNT = (int*)(ws + WS_CTL); float* MOD = (float*)(ws + WS_MOD);
    bf16_t* WinT = (bf16_t*)(ws + WS_WINT); bf16_t* WuqT = (bf16_t*)(ws + WS_WUQT); bf16_t* WukvT = (bf16_t*)(ws + WS_WUKVT); bf16_t* WoutT = (bf16_t*)(ws + WS_WOUTT);
    bf16_t* HX = (bf16_t*)(ws + WS_HX); bf16_t* G = (bf16_t*)(ws + WS_G); bf16_t* QLb = (bf16_t*)(ws + WS_QL); bf16_t* KVLb = (bf16_t*)(ws + WS_KVL); bf16_t* RK = (bf16_t*)(ws + WS_ROPEK);
    float* RSTDQ = (float*)(ws + WS_RSTDQ); float* RSTDKV = (float*)(ws + WS_RSTDKV);
    bf16_t* QRAW = (bf16_t*)(ws + WS_QRAW); bf16_t* KNRAW = (bf16_t*)(ws + WS_KNRAW); bf16_t* Vf = (bf16_t*)(ws + WS_VF); bf16_t* Qf = (bf16_t*)(ws + WS_QF); bf16_t* Kf = (bf16_t*)(ws + WS_KF);
    bf16_t* ATT = (bf16_t*)(ws + WS_ATT); bf16_t* T1 = (bf16_t*)(ws + WS_T1); bf16_t* Y = (bf16_t*)(ws + WS_Y); bf16_t* MIXA = (bf16_t*)(ws + WS_MIXA); bf16_t* HM = (bf16_t*)(ws + WS_HM);
    int* TOKE = (int*)(ws + WS_TOKE); int* TOKP = (int*)(ws + WS_TOKP); int* SLTOK = (int*)(ws + WS_SLTOK); float* SLW = (float*)(ws + WS_SLW);
    bf16_t* H = (bf16_t*)(ws + WS_H); bf16_t* YS = (bf16_t*)(ws + WS_YS); float* SC = (float*)(ws + WS_SC); float* SSQP = (float*)(ws + WS_SSQP);

    (void)hipMemsetAsync(ws + WS_CTL, 0, 65536, stream);
    (void)hipMemsetAsync(WinT + (size_t)3392 * D, 0, (size_t)192 * D * 2, stream);
    k_ada<<<dim3(NMOD / 256, 3), 256, 0, stream>>>(c, cctx, w_ada, b_ada, MOD);
    k_fold<<<2048, 256, 0, stream>>>(w_in, WinT);
    k_tcvt<<<dim3(1344 / 32, D / 32), 256, 0, stream>>>(w_in, nullptr, nullptr, WinT + (size_t)2048 * D, INP, 1024, D, 1344, 0, D);
    k_tcvt<<<dim3(1536 / 32, 768 / 32), 256, 0, stream>>>(w_uq, g_q_a, g_q_a, WuqT, 1536, 0, 768, 1536, 768, 768);
    k_tcvt<<<dim3(2048 / 32, 512 / 32), 256, 0, stream>>>(w_ukv, g_kv_a, g_kv_a, WukvT, 2048, 0, 512, 2048, 512, 512);
    k_tcvt<<<dim3(2048 / 32, 2048 / 32), 256, 0, stream>>>(w_out, g_of, g_oa, WoutT, 2048, 0, 2048, 2048, 1024, 2048);
    k_hx<<<NROW / 4, 256, 0, stream>>>(x, ctx, g1, MOD, HX);
    static int attr_ok = 0;
    if (!attr_ok) {
        if (hipFuncSetAttribute((const void*)k_g_inproj, hipFuncAttributeMaxDynamicSharedMemorySize, pg8::STAGE_BYTES) != hipSuccess ||
            hipFuncSetAttribute((const void*)k_g_qkv, hipFuncAttributeMaxDynamicSharedMemorySize, pg8::STAGE_BYTES) != hipSuccess ||
            hipFuncSetAttribute((const void*)k_g_out, hipFuncAttributeMaxDynamicSharedMemorySize, pg8::STAGE_BYTES) != hipSuccess ||
            hipFuncSetAttribute((const void*)k_attn, hipFuncAttributeMaxDynamicSharedMemorySize, att::SHM_ATTN) != hipSuccess ||
            hipFuncSetAttribute((const void*)k_moe_up_opt, hipFuncAttributeMaxDynamicSharedMemorySize, moe::LDS_BYTES) != hipSuccess ||
            hipFuncSetAttribute((const void*)k_moe_down_opt, hipFuncAttributeMaxDynamicSharedMemorySize, moe::LDS_BYTES) != hipSuccess) { fprintf(stderr, "hipFuncSetAttribute failed\n"); return; }
        attr_ok = 1; }
#if OPT_INPROJ
    k_g_inproj<<<256, 512, pg8::STAGE_BYTES, stream>>>(pg8::Gemm{HX, WinT, NROW, WIN_ROWS, D, D, D, 0}, pg8::EpiInproj{G, QLb, KVLb, RK, SSQP});
    k_rstd2<<<NROW / 256, 256, 0, stream>>>(SSQP, RSTDQ, RSTDKV);
#else
    gemm_naive<true><<<dim3(3392 / 64, NROW / 64, 1), 256, 0, stream>>>(NROW, 3392, D, 0, LdBf{HX, 0, D}, LdBfT{WinT, 0, D}, StInproj{G, QLb, KVLb, RK});
    k_rstd<<<NROW / 256, 256, 0, stream>>>(QLb, KVLb, RSTDQ, RSTDKV, SSQP);
#endif
#if OPT_QKV
    k_g_qkv<<<256, 512, pg8::STAGE_BYTES, stream>>>(pg8::Gemm{QLb, WuqT, NTOK, 1536, 768, 768, 768, 0}, pg8::EpiQ{QRAW, SSQP}, pg8::Gemm{KVLb, WukvT, NROW, 2048, 512, 512, 512, 0}, pg8::EpiKV{KNRAW, Vf, SSQP});
#else
    gemm_naive<true><<<dim3(1536 / 64, NTOK / 64, 1), 256, 0, stream>>>(NTOK, 1536, 768, 0, LdBf{QLb, 0, 768}, LdBfT{WuqT, 0, 768}, StQ{QRAW, RSTDQ});
    gemm_naive<true><<<dim3(2048 / 64, NROW / 64, 1), 256, 0, stream>>>(NROW, 2048, 512, 0, LdBf{KVLb, 0, 512}, LdBfT{WukvT, 0, 512}, StKV{KNRAW, Vf, RSTDKV});
#endif
    k_qkprep<<<(NTOK * NH + NROW * NH + 255) / 256, 256, 0, stream>>>(QRAW, KNRAW, RK, g_qk_q, g_qk_k, Qf, Kf);
#if OPT_ATTN
    k_attn<<<256, 512, att::SHM_ATTN, stream>>>(Qf, Kf, Vf, ATT);
#else
    for (int b = 0; b < 2; ++b) {
        gemm_naive<true><<<dim3(NKEY / 64, SEQ / 64, NH), 256, 0, stream>>>(SEQ, NKEY, HQK, 0, LdBf{Qf + (size_t)b * NH * SEQ * HQK, (size_t)SEQ * HQK, HQK}, LdBfT{Kf + (size_t)b * NH * NKEY * HQK, (size_t)NKEY * HQK, HQK}, StF{SC, (size_t)SEQ * NKEY, NKEY});
        k_softmax<<<NH * SEQ / 4, 256, 0, stream>>>(SC);
        gemm_naive<false><<<dim3(HV / 64, SEQ / 64, NH), 256, 0, stream>>>(SEQ, HV, NKEY, 0, LdF{SC, (size_t)SEQ * NKEY, NKEY}, LdBf{Vf + (size_t)b * NH * NKEY * HV, (size_t)NKEY * HV, HV}, StAtt{ATT, b});
    }
#endif
    k_dft1<<<dim3(4, SEQ, 2), 256, 0, stream>>>(G, T1);
    k_dft2<<<dim3(4, SEQ, 2), 256, 0, stream>>>(T1, Y);
    k_mixnorm<<<NTOK / 4, 256, 0, stream>>>(Y, ATT, MIXA);
#if OPT_OUT
    k_g_out<<<256, 512, pg8::STAGE_BYTES, stream>>>(pg8::Gemm{MIXA, WoutT, NTOK, D, 2048, 2048, 2048, 0}, pg8::EpiOut{out, x, MOD});
#else
    gemm_naive<true><<<dim3(D / 64, NTOK / 64, 1), 256, 0, stream>>>(NTOK, D, 2048, 0, LdBf{MIXA, 0, 2048}, LdBfT{WoutT, 0, 2048}, StOut{out, x, MOD});
#endif
    k_route<<<NTOK, 256, 0, stream>>>(out, g2, MOD, w_rg, b_rg, w_re, b_re, HM, CNT, TOKE, TOKP, SLTOK, SLW);
#if OPT_MOE
    k_moe_up_opt<<<256, 512, moe::LDS_BYTES, stream>>>(HM, SLTOK, w_gate, w_up, H, CNT);
#else
    k_moe_up<<<dim3(DE / 64, ECAP / 64, NEXP), 256, 0, stream>>>(HM, w_gate, w_up, CNT, SLTOK, H);
#endif
#if OPT_MOE
    k_moe_down_opt<<<256, 512, moe::LDS_BYTES, stream>>>(H, SLW, w_down, YS, CNT);
#else
    k_moe_down<<<dim3(D / 64, ECAP / 64, NEXP), 256, 0, stream>>>(H, w_down, CNT, SLW, YS);
#endif
    k_combine<<<NTOK, 256, 0, stream>>>(out, MOD, YS, CNT, TOKE, TOKP);
}

#endif
```
